# Optimizing an MI355X kernel written in HIP

```python
import math
import jax, jax.numpy as jnp
from jax import lax
import numpy as np

D_MODEL = 2048
BATCH = 1
SEQ = 8192
DEPTH = 2

HEAD_DIM = 128
DSW_GROUPS = ((128, 1), (512, 4), (2048, 16))
N_DSW_GROUPS = 3
DSW_HEADS = 8
MOBA_HEADS = 8
MOBA_BLOCK = 256
MOBA_TOPK = 3
MOBA_Q_CHUNK = 64
MLA_HEADS = 8
MLA_Q_RANK = 512
MLA_KV_RANK = 512
MLA_NOPE = 128
MLA_ROPE = 64
MLA_V = 128
MLA_QK = MLA_NOPE + MLA_ROPE
ROPE_THETA = 10000.0
Q_BLOCK = 128
REL_BUCKETS = 32
REL_MAX_DIST = 1024
N_BIAS_HEADS = N_DSW_GROUPS * DSW_HEADS + MOBA_HEADS
D_FF = 4 * D_MODEL
EPS = 1e-6

A_QKV = 3 * N_DSW_GROUPS * DSW_HEADS * HEAD_DIM
B_QKV = 3 * MOBA_HEADS * HEAD_DIM
C_IN = MLA_Q_RANK + MLA_KV_RANK + MLA_ROPE
D_IN = A_QKV + B_QKV + C_IN
A_OUT = DSW_HEADS * HEAD_DIM
B_OUT = MOBA_HEADS * HEAD_DIM
C_OUT = MLA_HEADS * MLA_V
N_BRANCH = 3

kernel_name = 'hybrid_gated_dilated_moba_mla_block'


def rms_norm(x, g):
    xf = x.astype(jnp.float32)
    y = xf * lax.rsqrt(jnp.mean(xf * xf, axis=-1, keepdims=True) + EPS)
    return (y * g.astype(jnp.float32)).astype(x.dtype)


def t5_bucket(dist):
    max_exact = REL_BUCKETS // 2
    n = jnp.maximum(dist, 0)
    nf = jnp.maximum(n, 1).astype(jnp.float32)
    large = max_exact + (jnp.log(nf / max_exact) / math.log(REL_MAX_DIST / max_exact)
                         * (REL_BUCKETS - max_exact)).astype(jnp.int32)
    large = jnp.minimum(large, REL_BUCKETS - 1)
    return jnp.where(n < max_exact, n, large)


def rope_tail(x, cos, sin):
    xn, xr = x[..., :MLA_NOPE], x[..., MLA_NOPE:]
    half = MLA_ROPE // 2
    x1 = xr[..., :half].astype(jnp.float32)
    x2 = xr[..., half:].astype(jnp.float32)
    cs, sn = cos[None, :, None, :], sin[None, :, None, :]
    xr = jnp.concatenate([x1 * cs - x2 * sn, x2 * cs + x1 * sn], axis=-1).astype(x.dtype)
    return jnp.concatenate([xn, xr], axis=-1)


def dilated_window_attention(q, k, v, bias_tab):
    B, S = q.shape[:2]
    scale = HEAD_DIM ** -0.5
    offs = jnp.arange(Q_BLOCK)
    groups = []
    for g, (win, dil) in enumerate(DSW_GROUPS):
        dists = jnp.arange(win // dil + 1) * dil
        bias = bias_tab[t5_bucket(dists)][:, g * DSW_HEADS:(g + 1) * DSW_HEADS].T
        groups.append((q[:, :, g], k[:, :, g], v[:, :, g], dists, bias))

    def block(bi):
        qpos = bi * Q_BLOCK + offs
        outs, lses = [], []
        for qg, kg, vg, dists, bias in groups:
            qb = lax.dynamic_slice_in_dim(qg, bi * Q_BLOCK, Q_BLOCK, axis=1)
            kidx = qpos[:, None] - dists[None, :]
            valid = kidx >= 0
            kidx = jnp.maximum(kidx, 0)
            kb = jnp.take(kg, kidx, axis=1)
            vb = jnp.take(vg, kidx, axis=1)
            s = jnp.einsum('bqhd,bqjhd->bhqj', qb, kb).astype(jnp.float32) * scale + bias[None, :, None, :]
            s = jnp.where(valid[None, None], s, -jnp.inf)
            m = jnp.max(s, axis=-1, keepdims=True)
            p = jnp.exp(s - m)
            l = jnp.sum(p, axis=-1, keepdims=True)
            outs.append(jnp.einsum('bhqj,bqjhd->bqhd', (p / l).astype(vg.dtype), vb))
            lses.append((m + jnp.log(l))[..., 0])
        wts = jax.nn.softmax(jnp.stack(lses), axis=0)
        outs = jnp.stack(outs)
        return jnp.einsum('gbhq,gbqhd->bqhd', wts.astype(outs.dtype), outs)

    out = lax.map(block, jnp.arange(S // Q_BLOCK))
    return out.transpose(1, 0, 2, 3, 4).reshape(B, S, A_OUT)


def moba_attention(q, k, v, bias_tab):
    B, S, H, dh = q.shape
    L = MOBA_BLOCK
    nb = -(-S // L)
    topk = min(MOBA_TOPK, nb)
    pad = nb * L - S
    kp = jnp.pad(k, ((0, 0), (0, pad), (0, 0), (0, 0)))
    vp = jnp.pad(v, ((0, 0), (0, pad), (0, 0), (0, 0)))
    kbt = kp.reshape(B, nb, L, H, dh).transpose(0, 3, 1, 2, 4)
    vbt = vp.reshape(B, nb, L, H, dh).transpose(0, 3, 1, 2, 4)
    kbar = jnp.mean(kbt.astype(jnp.float32), axis=3)
    qblk = jnp.arange(S) // L
    gate = jnp.einsum('bshd,bhnd->bhsn', q.astype(jnp.float32), kbar)
    past = jnp.arange(nb)[None, :] < qblk[:, None]
    gate = jnp.where(past[None, None], gate, -jnp.inf)
    _, sel = lax.top_k(gate, topk)
    sel_valid = sel < qblk[None, None, :, None]
    scale = HEAD_DIM ** -0.5
    b_i = jnp.arange(B)[:, None, None, None]
    h_i = jnp.arange(H)[None, :, None, None]
    h_i5 = jnp.arange(H)[None, :, None, None, None]
    tb = bias_tab.T
    C = MOBA_Q_CHUNK
    karange = jnp.arange(L)

    def chunk(ci):
        p0 = ci * C
        qpos = p0 + jnp.arange(C)
        qc = lax.dynamic_slice_in_dim(q, p0, C, axis=1)
        selc = lax.dynamic_slice_in_dim(sel, p0, C, axis=2)
        valc = lax.dynamic_slice_in_dim(sel_valid, p0, C, axis=2)
        ksel = kbt[b_i, h_i, selc]
        vsel = vbt[b_i, h_i, selc]
        s_sel = jnp.einsum('bqhd,bhqkld->bhqkl', qc, ksel).astype(jnp.float32) * scale
        kpos_sel = selc[..., None] * L + karange
        bkt = t5_bucket(qpos[None, None, :, None, None] - kpos_sel)
        s_sel = s_sel + tb[h_i5, bkt]
        s_sel = jnp.where(valc[..., None], s_sel, -jnp.inf)
        blk = p0 // L
        kown = lax.dynamic_slice_in_dim(kp, blk * L, L, axis=1)
        vown = lax.dynamic_slice_in_dim(vp, blk * L, L, axis=1)
        kpos_own = blk * L + karange
        s_own = jnp.einsum('bqhd,blhd->bhql', qc, kown).astype(jnp.float32) * scale
        s_own = s_own + bias_tab[t5_bucket(qpos[:, None] - kpos_own[None, :])].transpose(2, 0, 1)[None]
        s_own = jnp.where((kpos_own[None, :] <= qpos[:, None])[None, None], s_own, -jnp.inf)
        s = jnp.concatenate([s_sel.reshape(B, H, C, topk * L), s_own], axis=-1)
        p = jax.nn.softmax(s, axis=-1).astype(v.dtype)
        o = jnp.einsum('bhqm,bhqmd->bqhd', p[..., :topk * L], vsel.reshape(B, H, C, topk * L, dh))
        return o + jnp.einsum('bhql,blhd->bqhd', p[..., topk * L:], vown)

    out = lax.map(chunk, jnp.arange(S // C))
    return out.transpose(1, 0, 2, 3, 4).reshape(B, S, B_OUT)


def causal_mla_attention(q, k, v):
    B, S, H, _ = q.shape
    scale = MLA_QK ** -0.5
    kpos = jnp.arange(S)

    def block(bi):
        qb = lax.dynamic_slice_in_dim(q, bi * Q_BLOCK, Q_BLOCK, axis=1)
        qpos = bi * Q_BLOCK + jnp.arange(Q_BLOCK)
        s = jnp.einsum('bqhd,bkhd->bhqk', qb, k).astype(jnp.float32) * scale
        s = jnp.where((kpos[None, :] <= qpos[:, None])[None, None], s, -jnp.inf)
        p = jax.nn.softmax(s, axis=-1).astype(v.dtype)
        return jnp.einsum('bhqk,bkhd->bqhd', p, v)

    out = lax.map(block, jnp.arange(S // Q_BLOCK))
    return out.transpose(1, 0, 2, 3, 4).reshape(B, S, C_OUT)


def hybrid_mixer(h, cos, sin, rel_bias, w_in, q_a_norm_g, w_q_b, kv_a_norm_g, w_kv_b,
                 qn_a, kn_a, qn_b, kn_b, qn_c, kn_c, w_gate, b_gate, w_br_a, w_br_b, w_br_c, w_o):
    B, S, _ = h.shape
    z = h @ w_in
    za, zb, zc = z[..., :A_QKV], z[..., A_QKV:A_QKV + B_QKV], z[..., A_QKV + B_QKV:]
    za = za.reshape(B, S, 3, N_DSW_GROUPS, DSW_HEADS, HEAD_DIM)
    qa, ka, va = rms_norm(za[:, :, 0], qn_a), rms_norm(za[:, :, 1], kn_a), za[:, :, 2]
    ya = dilated_window_attention(qa, ka, va, rel_bias[:, :N_DSW_GROUPS * DSW_HEADS])
    zb = zb.reshape(B, S, 3, MOBA_HEADS, HEAD_DIM)
    qb, kb, vb = rms_norm(zb[:, :, 0], qn_b), rms_norm(zb[:, :, 1], kn_b), zb[:, :, 2]
    yb = moba_attention(qb, kb, vb, rel_bias[:, N_DSW_GROUPS * DSW_HEADS:])
    cq = zc[..., :MLA_Q_RANK]
    ckv = zc[..., MLA_Q_RANK:MLA_Q_RANK + MLA_KV_RANK]
    kpe = zc[..., MLA_Q_RANK + MLA_KV_RANK:]
    qc = (rms_norm(cq, q_a_norm_g) @ w_q_b).reshape(B, S, MLA_HEADS, MLA_QK)
    kv = (rms_norm(ckv, kv_a_norm_g) @ w_kv_b).reshape(B, S, MLA_HEADS, MLA_NOPE + MLA_V)
    k_nope, vc = kv[..., :MLA_NOPE], kv[..., MLA_NOPE:]
    kc = jnp.concatenate([k_nope, jnp.broadcast_to(kpe[:, :, None, :], (B, S, MLA_HEADS, MLA_ROPE))], axis=-1)
    qc = rope_tail(rms_norm(qc, qn_c), cos, sin)
    kc = rope_tail(rms_norm(kc, kn_c), cos, sin)
    yc = causal_mla_attention(qc, kc, vc)
    g = jax.nn.sigmoid(h @ w_gate + b_gate).reshape(B, S, N_BRANCH, D_MODEL)
    merged = g[:, :, 0] * (ya @ w_br_a) + g[:, :, 1] * (yb @ w_br_b) + g[:, :, 2] * (yc @ w_br_c)
    return merged @ w_o


def squared_relu_mlp(h, w_up, w_down):
    return jnp.square(jax.nn.relu(h @ w_up)) @ w_down


def setup_inputs(seed: int = 0) -> dict:
    key = jax.random.key(seed)
    ks = jax.random.split(key, 32)
    f32 = jnp.float32
    D = D_MODEL

    def w(k, shape, fan_in):
        return jax.random.normal(k, shape, f32) * fan_in ** -0.5

    def gain(k, shape):
        return 1.0 + 0.02 * jax.random.normal(k, shape, f32)

    return {
        'x': jax.random.normal(ks[0], (BATCH, SEQ, D), f32),
        'c': jax.random.normal(ks[1], (BATCH, D), f32),
        'rel_bias': 0.5 * jax.random.normal(ks[2], (REL_BUCKETS, N_BIAS_HEADS), f32),
        'ada_w': w(ks[3], (DEPTH, D, 6 * D), D),
        'ada_b': 0.02 * jax.random.normal(ks[4], (DEPTH, 6 * D), f32),
        'norm_mix_g': gain(ks[5], (DEPTH, D)),
        'w_in': w(ks[6], (DEPTH, D, D_IN), D),
        'q_a_norm_g': gain(ks[7], (DEPTH, MLA_Q_RANK)),
        'w_q_b': w(ks[8], (DEPTH, MLA_Q_RANK, MLA_HEADS * MLA_QK), MLA_Q_RANK),
        'kv_a_norm_g': gain(ks[9], (DEPTH, MLA_KV_RANK)),
        'w_kv_b': w(ks[10], (DEPTH, MLA_KV_RANK, MLA_HEADS * (MLA_NOPE + MLA_V)), MLA_KV_RANK),
        'qn_a': gain(ks[11], (DEPTH, HEAD_DIM)),
        'kn_a': gain(ks[12], (DEPTH, HEAD_DIM)),
        'qn_b': gain(ks[13], (DEPTH, HEAD_DIM)),
        'kn_b': gain(ks[14], (DEPTH, HEAD_DIM)),
        'qn_c': gain(ks[15], (DEPTH, MLA_QK)),
        'kn_c': gain(ks[16], (DEPTH, MLA_QK)),
        'w_gate': w(ks[17], (DEPTH, D, N_BRANCH * D), D),
        'b_gate': 0.02 * jax.random.normal(ks[18], (DEPTH, N_BRANCH * D), f32),
        'w_br_a': w(ks[19], (DEPTH, A_OUT, D), A_OUT),
        'w_br_b': w(ks[20], (DEPTH, B_OUT, D), B_OUT),
        'w_br_c': w(ks[21], (DEPTH, C_OUT, D), C_OUT),
        'w_o': w(ks[22], (DEPTH, D, D), D),
        'norm_mlp_g': gain(ks[23], (DEPTH, D)),
        'w_up': w(ks[24], (DEPTH, D, D_FF), D),
        'w_down': w(ks[25], (DEPTH, D_FF, D), D_FF),
    }


def reference(x, c, rel_bias, ada_w, ada_b, norm_mix_g, w_in, q_a_norm_g, w_q_b, kv_a_norm_g, w_kv_b,
              qn_a, kn_a, qn_b, kn_b, qn_c, kn_c, w_gate, b_gate, w_br_a, w_br_b, w_br_c, w_o,
              norm_mlp_g, w_up, w_down):
    S = x.shape[1]
    pos = jnp.arange(S, dtype=jnp.float32)
    inv_freq = ROPE_THETA ** (-jnp.arange(0, MLA_ROPE, 2, dtype=jnp.float32) / MLA_ROPE)
    ang = pos[:, None] * inv_freq[None, :]
    cos, sin = jnp.cos(ang), jnp.sin(ang)
    c_act = jax.nn.silu(c)
    for l in range(DEPTH):
        mod = (c_act @ ada_w[l] + ada_b[l])[:, None, :]
        sh1, sc1, g1, sh2, sc2, g2 = jnp.split(mod, 6, axis=-1)
        h = rms_norm(x, norm_mix_g[l]) * (1 + sc1) + sh1
        x = x + g1 * hybrid_mixer(h, cos, sin, rel_bias, w_in[l], q_a_norm_g[l], w_q_b[l],
                                  kv_a_norm_g[l], w_kv_b[l], qn_a[l], kn_a[l], qn_b[l], kn_b[l],
                                  qn_c[l], kn_c[l], w_gate[l], b_gate[l], w_br_a[l], w_br_b[l],
                                  w_br_c[l], w_o[l])
        h = rms_norm(x, norm_mlp_g[l]) * (1 + sc2) + sh2
        x = x + g2 * squared_relu_mlp(h, w_up[l], w_down[l])
    return x
```

```cpp
#include <hip/hip_runtime.h>
#include <hip/hip_bf16.h>
#include <hip/hip_cooperative_groups.h>
#include <cstdio>
#include <cstdint>
namespace cg = cooperative_groups;

#define LAS __attribute__((address_space(3)))
typedef unsigned short bf16_t;
typedef short bf16x8 __attribute__((ext_vector_type(8)));
typedef short s16x4 __attribute__((ext_vector_type(4)));
typedef float f32x4 __attribute__((ext_vector_type(4)));
typedef float f32x2 __attribute__((ext_vector_type(2)));
typedef float f32x16 __attribute__((ext_vector_type(16)));
typedef unsigned u32x4 __attribute__((ext_vector_type(4)));
typedef unsigned u32x2 __attribute__((ext_vector_type(2)));
typedef int v4i __attribute__((ext_vector_type(4)));
typedef int v8i __attribute__((ext_vector_type(8)));

constexpr int S = 8192, D = 2048, DFF = 8192;
constexpr int ZW = 13568;
constexpr int GW = 6144;
constexpr int NIN = ZW + GW;
constexpr int ZC_AQ = 0, ZC_AK = 3072, ZC_AV = 6144, ZC_BQ = 9216, ZC_BK = 10240, ZC_BV = 11264, ZC_CQ = 12288, ZC_CKV = 12800, ZC_KPE = 13312;
constexpr float EPS = 1e-6f;
constexpr int NT = 512;
constexpr int KSPLIT = 16;
constexpr int BTA = 129, BTA_STRIDE = 132, BTB = 800;

constexpr size_t MiB = 1u << 20;
constexpr size_t OFF_CTL = 0;
constexpr size_t OFF_MODP = 1 * MiB;
constexpr size_t OFF_BTAB = 3 * MiB;
constexpr size_t OFF_KBAR = 4 * MiB;
constexpr size_t OFF_LIST = 5 * MiB;
constexpr size_t OFF_LSE = 13 * MiB;
constexpr size_t OFF_WT = 16 * MiB;
constexpr size_t WT_IN = 0, WT_QB = 77 * MiB, WT_KVB = WT_QB + 3 * MiB / 2, WT_BR = WT_KVB + 2 * MiB, WT_O = WT_BR + 12 * MiB, WT_UP = WT_O + 8 * MiB, WT_DN = WT_UP + 32 * MiB;
constexpr size_t OFF_Z = OFF_WT + 165 * MiB;
constexpr size_t OFF_U = OFF_Z, OFF_Y = OFF_Z + 128 * MiB, OFF_MERGED = OFF_Z + 176 * MiB;
constexpr size_t OFF_GATES = OFF_Z + 212 * MiB;
constexpr size_t OFF_H = OFF_GATES + 96 * MiB;
constexpr size_t OFF_QRAW = OFF_H + 32 * MiB;
constexpr size_t OFF_KVRAW = OFF_QRAW + 24 * MiB;
constexpr size_t OFF_QC = OFF_KVRAW + 32 * MiB;
constexpr size_t OFF_KC = OFF_QC + 24 * MiB;
constexpr size_t OFF_PA = OFF_KC + 24 * MiB;
constexpr size_t OFF_PB = OFF_PA + 48 * MiB;
constexpr size_t OFF_PC = OFF_PB + 64 * MiB;
constexpr size_t OFF_X1 = OFF_PC + 32 * MiB;
constexpr size_t WS_END = OFF_X1 + 64 * MiB;
static_assert(WT_DN + 32 * MiB <= 165 * MiB, "weights");
constexpr int CW_CNT = 0;
constexpr int CW_QCTR = 1024;
constexpr int CW_BAR = 4096;
constexpr int LDS_MISC = 135168;
constexpr int LDS_XCH = 136192;
constexpr size_t OFF_SSQC = OFF_KBAR + 512 * 1024;

constexpr int LDS_BYTES = 147456;

struct Params { const float* in[26]; float* out; unsigned char* ws; };

constexpr int LDS_WTAB = 135168 + 64;
__device__ __forceinline__ int otid() {
    extern __shared__ __attribute__((aligned(16))) unsigned char lds_raw[];
    const unsigned hw = __builtin_amdgcn_s_getreg((5 << 11) | 4) & 63u;
    const int wid = ((const volatile LAS int*)((LAS unsigned char*)lds_raw + LDS_WTAB))[hw];
    int t = __builtin_amdgcn_readfirstlane(wid) * 64 + (int)__builtin_amdgcn_mbcnt_hi(~0u, __builtin_amdgcn_mbcnt_lo(~0u, 0u));
    asm volatile("" : "+v"(t)); return t; }
__device__ __forceinline__ int obid() { int b = blockIdx.x; asm volatile("" : "+s"(b)); return b; }
typedef __bf16 bf16v2 __attribute__((ext_vector_type(2)));
__device__ __forceinline__ unsigned cvtpk(float lo, float hi) { f32x2 v = {lo, hi}; bf16v2 b = __builtin_convertvector(v, bf16v2); return __builtin_bit_cast(unsigned, b); }
__device__ __forceinline__ unsigned cvtpk_c(float lo, float hi) { f32x2 v = {lo, hi}; bf16v2 b = __builtin_convertvector(v, bf16v2); return __builtin_bit_cast(unsigned, b); }
__device__ __forceinline__ unsigned pk4_fp8(float a, float b, float c, float d) { int v = 0; v = __builtin_amdgcn_cvt_pk_fp8_f32(a, b, v, false); v = __builtin_amdgcn_cvt_pk_fp8_f32(c, d, v, true); return (unsigned)v; }
__device__ __forceinline__ float bf2f(unsigned short h) { return __uint_as_float(((unsigned)h) << 16); }
__device__ __forceinline__ float bflo(unsigned w) { return __uint_as_float(w << 16); }
__device__ __forceinline__ float bfhi(unsigned w) { return __uint_as_float(w & 0xffff0000u); }
__device__ __forceinline__ float wave_sum(float v) {
#pragma unroll
    for (int o = 1; o < 64; o <<= 1) v += __shfl_xor(v, o);
    return v;
}
__device__ __forceinline__ float mod_at(const float* modp, const float* ada_b, int layer, int idx) {
    float s = ada_b[layer * 12288 + idx];
#pragma unroll
    for (int ks = 0; ks < KSPLIT; ++ks) s += modp[(size_t)(layer * KSPLIT + ks) * 12288 + idx];
    return s;
}
__device__ __forceinline__ int t5_bucket(int n) {
    if (n < 16) return n;
    const float nf = (float)n;
    int large = 16 + (int)(logf(nf / 16.f) / 4.1588830833596715f * 16.f);
    return large < 31 ? large : 31;
}

namespace pg8 {
constexpr int BM = 256, BK = 64, HALF = 128, HTB = HALF * BK * 2, STAGE_BYTES = 8 * HTB, NXCD = 8, WGM = 8;
__host__ __device__ __forceinline__ int lds_byte(int r, int c) { const int st = (r >> 4) * 2 + (c >> 5), rr = r & 15, cc = c & 31, ob = rr * 64 + cc * 2; return st * 1024 + (ob ^ (((ob >> 9) & 1) << 5)); }
__host__ __device__ __forceinline__ void stage_rc(int b, int& R, int& C) { const int st = b / 1024, sb = b % 1024, swz = sb ^ (((sb >> 9) & 1) << 5); R = (st >> 1) * 16 + swz / 64; C = (st & 1) * 32 + (swz % 64) / 2; }
__host__ __device__ __forceinline__ int perm32(int rho) { const int n = rho >> 4, i = rho & 15; return 8 * (i >> 2) + 4 * n + (i & 3); }

struct Unit { int pm, pn, z; };
struct Gemm { const bf16_t* A; const bf16_t* Bt; int K; int lda, ldb; size_t zA, zB; };

struct StaticOrder {
    int nM, nN, nwg, G, c;
    __device__ void init(int M, int N, int G_, int c_) { nM = M / BM; nN = N / BM; nwg = nM * nN; G = G_; c = c_; }
    __device__ bool next(int i, Unit& u) const {
        const long L = (long)i * G + c; if (L >= nwg) return false;
        int wgid = (int)L; { const int q = nwg / NXCD, r = nwg % NXCD, xcd = wgid % NXCD, off = wgid / NXCD; wgid = (xcd < r ? xcd * (q + 1) : r * (q + 1) + (xcd - r) * q) + off; }
        const int nig = WGM * nN, gid = wgid / nig, fm = gid * WGM, gsz = (nM - fm) < WGM ? (nM - fm) : WGM;
        u.pm = fm + ((wgid % nig) % gsz); u.pn = (wgid % nig) / gsz; u.z = 0; return true;
    }
};
struct BranchOrder {
    int G, c;
    __device__ bool next(int i, Unit& u) const { const int tile = c + (i / 3) * G; if (tile >= 256) return false; u.pm = tile >> 3; u.pn = tile & 7; u.z = i % 3; return true; }
};

template <bool FP8> struct FragT { struct T { bf16x8 k[2]; }; };
template <> struct FragT<true> { struct T { v8i v; }; };
__device__ __forceinline__ void ldfrag(FragT<false>::T& f, const LAS unsigned char* p) { f.k[0] = *(const LAS bf16x8*)p; f.k[1] = *(const LAS bf16x8*)(p + 1024); }
__device__ __forceinline__ void ldfrag(FragT<true>::T& f, const LAS unsigned char* p) { f.v = *(const LAS v8i*)p; }
__device__ __forceinline__ void mma1(f32x4& c, const FragT<false>::T& a, const FragT<false>::T& b) {
    c = __builtin_amdgcn_mfma_f32_16x16x32_bf16(a.k[0], b.k[0], c, 0, 0, 0); c = __builtin_amdgcn_mfma_f32_16x16x32_bf16(a.k[1], b.k[1], c, 0, 0, 0); }
__device__ __forceinline__ void mma1(f32x4& c, const FragT<true>::T& a, const FragT<true>::T& b) {
#if defined(__HIP_DEVICE_COMPILE__)
    const int sa = 0x79797979, sb = 0x7F7F7F7F;
    asm volatile("s_nop 1\n\tv_mfma_scale_f32_16x16x128_f8f6f4 %0, %1, %2, %0, %3, %4 op_sel_hi:[0,0,0]" : "+v"(c) : "v"(a.v), "v"(b.v), "v"(sa), "v"(sb));
#endif
}
template <class Epi, class Sched, bool ALIGN_EPI, bool FP8 = false>
__device__ __forceinline__ void gemm_phase(LAS unsigned char* lds, const Gemm g, const Sched& S, const Epi& E) {
    const int tid = otid(), wid = __builtin_amdgcn_readfirstlane(tid >> 6), lane = tid & 63, wr = wid >> 2, wc = wid & 3, fr = lane & 15, fq = lane >> 4;
    constexpr int ES = FP8 ? 1 : 2;
    const int K = g.K, nt = K * ES / 128;
    unsigned voffA[2], voffB[2];
#pragma unroll
    for (int i = 0; i < 2; ++i) { int R, C; stage_rc(tid * 16 + i * 8192, R, C); const int Rb = Epi::PERM ? ((R & ~31) + perm32(R & 31)) : R;
        voffA[i] = (unsigned)(R * g.lda * ES + C * 2); voffB[i] = (unsigned)(Rb * g.ldb * ES + C * 2); }
    const size_t kstep = (size_t)(BK * 2);
    const size_t hstepA = (size_t)HALF * g.lda * ES, hstepB = (size_t)HALF * g.ldb * ES;
    const size_t tstepA = 2 * hstepA, tstepB = 2 * hstepB;
    const unsigned ldsw = (unsigned)wid * 1024u;
    const int aoff = FP8 ? lds_byte(wr * 64 + fr, ((2 * fq) & 3) * 8) + (fq >> 1) * 1024 : lds_byte(wr * 64 + fr, fq * 8);
    const int boff = FP8 ? lds_byte(wc * 32 + fr, ((2 * fq) & 3) * 8) + (fq >> 1) * 1024 : lds_byte(wc * 32 + fr, fq * 8);
#define PG8_SA(b, h) (((b) * 2 + (h)) * HTB)
#define PG8_SB(b, h) ((4 + (b) * 2 + (h)) * HTB)
#define PG8_STAGE(bufoff, gbase, voff) do { _Pragma("unroll") for (int _i = 0; _i < 2; ++_i) \
        __builtin_amdgcn_global_load_lds((const unsigned*)((const char*)(gbase) + (voff)[_i]), (LAS unsigned*)(lds + (bufoff) + ldsw + _i * 8192), 16, 0, 0); } while (0)
#define PG8_LDA(dst, b, h) do { _Pragma("unroll") for (int m = 0; m < 4; ++m) ldfrag(dst[m], lds + PG8_SA(b, h) + aoff + m * 2048); } while (0)
#define PG8_LDB(dst, b, h) do { _Pragma("unroll") for (int n = 0; n < 2; ++n) ldfrag(dst[n], lds + PG8_SB(b, h) + boff + n * 2048); } while (0)
#define PG8_MMA(ai, bj, At, Bt) do { __builtin_amdgcn_s_setprio(1); _Pragma("unroll") for (int m = 0; m < 4; ++m) _Pragma("unroll") for (int n = 0; n < 2; ++n) mma1(acc[ai][bj][m][n], Bt[n], At[m]); __builtin_amdgcn_s_setprio(0); } while (0)
#define PG8_WAIT_V(n) asm volatile("s_waitcnt vmcnt(" #n ")" ::: "memory")
#define PG8_WAIT_L(n) asm volatile("s_waitcnt lgkmcnt(" #n ")" ::: "memory")
#define PG8_BAR __builtin_amdgcn_s_barrier()
#define PG8_SCHED __builtin_amdgcn_sched_barrier(0)
    Unit cur, nxt; int ui = 0;
    if (!S.next(0, cur)) return;
    f32x4 acc[2][2][4][2];
#pragma unroll
    for (int a = 0; a < 2; ++a)
#pragma unroll
        for (int b = 0; b < 2; ++b)
#pragma unroll
            for (int m = 0; m < 4; ++m)
#pragma unroll
                for (int n = 0; n < 2; ++n) acc[a][b][m][n] = (f32x4){0.f, 0.f, 0.f, 0.f};
    typedef typename FragT<FP8>::T Frag;
    Frag At[4], B0[2], B1[2];
    const char* cA = (const char*)g.A + (size_t)cur.pm * tstepA + (size_t)cur.z * g.zA; const char* cB = (const char*)g.Bt + (size_t)cur.pn * tstepB + (size_t)cur.z * g.zB;
    PG8_STAGE(PG8_SB(0, 0), cB, voffB); PG8_STAGE(PG8_SB(0, 1), cB + hstepB, voffB); PG8_STAGE(PG8_SA(0, 0), cA, voffA); PG8_STAGE(PG8_SA(0, 1), cA + hstepA, voffA);
    if (wr == 1) PG8_BAR;
    PG8_WAIT_V(2); PG8_BAR;
    PG8_STAGE(PG8_SB(1, 0), cB + kstep, voffB); PG8_STAGE(PG8_SA(1, 0), cA + kstep, voffA); PG8_STAGE(PG8_SB(1, 1), cB + hstepB + kstep, voffB);
    PG8_WAIT_V(6); PG8_BAR;
    for (;;) {
        const bool has_next = S.next(ui + 1, nxt);
        const char* nA = has_next ? (const char*)g.A + (size_t)nxt.pm * tstepA + (size_t)nxt.z * g.zA : cA; const char* nB = has_next ? (const char*)g.Bt + (size_t)nxt.pn * tstepB + (size_t)nxt.z * g.zB : cB;
        for (int t = 0; t < nt; t += 2) {
            const bool last = (t == nt - 2);
            const char* a1 = cA + (size_t)(t + 1) * kstep;
            const char* a2 = last ? nA : cA + (size_t)(t + 2) * kstep; const char* b2 = last ? nB : cB + (size_t)(t + 2) * kstep;
            const char* a3 = a2 + kstep; const char* b3 = b2 + kstep;
            PG8_LDB(B0, 0, 0); PG8_LDB(B1, 0, 1); PG8_SCHED; PG8_LDA(At, 0, 0); PG8_STAGE(PG8_SA(1, 1), a1 + hstepA, voffA);
            PG8_WAIT_V(8); PG8_WAIT_L(0); PG8_BAR; PG8_MMA(0, 0, At, B0); PG8_MMA(0, 1, At, B1); PG8_BAR; PG8_SCHED;
            PG8_LDA(At, 0, 1); PG8_STAGE(PG8_SB(0, 0), b2, voffB); PG8_STAGE(PG8_SB(0, 1), b2 + hstepB, voffB); PG8_STAGE(PG8_SA(0, 0), a2, voffA);
            PG8_WAIT_V(8); PG8_WAIT_L(0); PG8_BAR; PG8_MMA(1, 0, At, B0); PG8_MMA(1, 1, At, B1); PG8_BAR; PG8_SCHED;
            PG8_LDB(B0, 1, 0); PG8_LDB(B1, 1, 1); PG8_SCHED; PG8_LDA(At, 1, 0); PG8_STAGE(PG8_SA(0, 1), a2 + hstepA, voffA);
            PG8_WAIT_V(8); PG8_WAIT_L(0); PG8_BAR; PG8_MMA(0, 0, At, B0); PG8_MMA(0, 1, At, B1); PG8_BAR; PG8_SCHED;
            PG8_LDA(At, 1, 1); PG8_STAGE(PG8_SB(1, 0), b3, voffB); PG8_STAGE(PG8_SB(1, 1), b3 + hstepB, voffB); PG8_STAGE(PG8_SA(1, 0), a3, voffA);
            PG8_WAIT_V(8); PG8_WAIT_L(0); PG8_BAR; PG8_MMA(1, 0, At, B0); PG8_MMA(1, 1, At, B1); PG8_BAR; PG8_SCHED;
        }
        if constexpr (ALIGN_EPI) { if (wr == 0) PG8_BAR; }
        if constexpr (FP8) asm volatile("s_nop 15\n\ts_nop 15\n\ts_nop 7" ::: "memory");
        E(acc, cur, wr, wc, fr, fq);
        if (!has_next) break;
#pragma unroll
        for (int a = 0; a < 2; ++a)
#pragma unroll
            for (int b = 0; b < 2; ++b)
#pragma unroll
                for (int m = 0; m < 4; ++m)
#pragma unroll
                    for (int n = 0; n < 2; ++n) acc[a][b][m][n] = (f32x4){0.f, 0.f, 0.f, 0.f};
        cur = nxt; cA = nA; cB = nB; ++ui;
        if constexpr (ALIGN_EPI) { if (wr == 1) PG8_BAR; }
    }
    PG8_WAIT_V(0);
    if constexpr (!ALIGN_EPI) { if (wr == 0) PG8_BAR; }
    PG8_BAR;
#undef PG8_SA
#undef PG8_SB
#undef PG8_STAGE
#undef PG8_LDA
#undef PG8_LDB
#undef PG8_MMA
#undef PG8_WAIT_V
#undef PG8_WAIT_L
#undef PG8_BAR
#undef PG8_SCHED
}

typedef f32x4 Acc[2][2][4][2];
__device__ __forceinline__ float sigm(float x) { return __builtin_amdgcn_rcpf(1.f + __builtin_amdgcn_exp2f(x * -1.4426950408889634f)); }

struct EpiIn {
    static constexpr bool PERM = true;
    bf16_t* z; bf16_t* gates; const float* b_gate; const float* qn_a; const float* kn_a; const float* qn_b; const float* kn_b; float* ssqC; LAS float* xch;
    __device__ __forceinline__ void operator()(const Acc& acc, const Unit& u, int wr, int wc, int fr, int fq) const {
        const int colt = u.pn * BM;
        if (colt < ZW) {
            int lg = 0; if (colt < 9216) { const int gi = (colt % 3072) >> 10; lg = 2 * gi; }
            const float* gain = nullptr;
            if (colt < 3072) gain = qn_a; else if (colt < 6144) gain = kn_a; else if (colt >= ZC_BQ && colt < ZC_BK) gain = qn_b; else if (colt >= ZC_BK && colt < ZC_BV) gain = kn_b;
            const bool isC = colt >= ZC_CQ && colt < ZC_KPE;
            const int col0 = colt + wc * 32 + 8 * fq;
            float rs[2][4][2];
            f32x4 g0 = {1.f, 1.f, 1.f, 1.f}, g1 = g0;
            if (gain != nullptr || isC) {
#pragma unroll
                for (int ai = 0; ai < 2; ++ai)
#pragma unroll
                    for (int m = 0; m < 4; ++m)
#pragma unroll
                        for (int bj = 0; bj < 2; ++bj) { const f32x4 a = acc[ai][bj][m][0], b = acc[ai][bj][m][1];
                            float s = (a[0] * a[0] + a[1] * a[1]) + (a[2] * a[2] + a[3] * a[3]) + (b[0] * b[0] + b[1] * b[1]) + (b[2] * b[2] + b[3] * b[3]);
                            s += __shfl_xor(s, 16); s += __shfl_xor(s, 32);
                            if (fq == 0) xch[((ai * HALF + wr * 64 + m * 16 + fr) * 2 + bj) * 4 + wc] = s; }
                asm volatile("s_waitcnt lgkmcnt(0)" ::: "memory"); __builtin_amdgcn_s_barrier(); asm volatile("" ::: "memory");
#pragma unroll
                for (int ai = 0; ai < 2; ++ai)
#pragma unroll
                    for (int m = 0; m < 4; ++m) { const int rl = ai * HALF + wr * 64 + m * 16 + fr;
                        const f32x4 t0 = *(const LAS f32x4*)(xch + (rl * 2 + 0) * 4), t1 = *(const LAS f32x4*)(xch + (rl * 2 + 1) * 4);
                        const float s0 = (t0[0] + t0[1]) + (t0[2] + t0[3]), s1 = (t1[0] + t1[1]) + (t1[2] + t1[3]);
                        if (gain != nullptr) { rs[ai][m][0] = __builtin_amdgcn_rsqf(s0 * (1.f / 128.f) + EPS); rs[ai][m][1] = __builtin_amdgcn_rsqf(s1 * (1.f / 128.f) + EPS); }
                        else { rs[ai][m][0] = 1.f; rs[ai][m][1] = 1.f; if (wc == 0 && fq == 0) ssqC[(size_t)(u.pm * BM + rl) * 4 + ((colt - ZC_CQ) >> 8)] = s0 + s1; } }
                if (gain != nullptr) { g0 = *(const f32x4*)(gain + wc * 32 + 8 * fq); g1 = *(const f32x4*)(gain + wc * 32 + 8 * fq + 4); }
            } else {
#pragma unroll
                for (int ai = 0; ai < 2; ++ai)
#pragma unroll
                    for (int m = 0; m < 4; ++m) { rs[ai][m][0] = 1.f; rs[ai][m][1] = 1.f; }
            }
#pragma unroll
            for (int ai = 0; ai < 2; ++ai)
#pragma unroll
                for (int m = 0; m < 4; ++m) {
                    const int r = u.pm * BM + ai * HALF + wr * 64 + m * 16 + fr;
                    const int zr = ((r & ((1 << lg) - 1)) << (13 - lg)) + (r >> lg);
                    bf16_t* rowp = z + (size_t)zr * ZW + col0;
#pragma unroll
                    for (int bj = 0; bj < 2; ++bj) { const f32x4 v0 = acc[ai][bj][m][0] * rs[ai][m][bj] * g0, v1 = acc[ai][bj][m][1] * rs[ai][m][bj] * g1;
                        u32x4 w; w.x = cvtpk(v0[0], v0[1]); w.y = cvtpk(v0[2], v0[3]); w.z = cvtpk(v1[0], v1[1]); w.w = cvtpk(v1[2], v1[3]);
                        __builtin_nontemporal_store(w, (u32x4*)(rowp + bj * HALF)); }
                }
        } else {
            const int col0 = colt - ZW + wc * 32 + 8 * fq;
            f32x4 bv[2][2];
#pragma unroll
            for (int bj = 0; bj < 2; ++bj)
#pragma unroll
                for (int n = 0; n < 2; ++n) bv[bj][n] = *(const f32x4*)(b_gate + col0 + bj * HALF + 4 * n);
#pragma unroll
            for (int ai = 0; ai < 2; ++ai)
#pragma unroll
                for (int m = 0; m < 4; ++m) {
                    const int r = u.pm * BM + ai * HALF + wr * 64 + m * 16 + fr;
                    bf16_t* rowp = gates + (size_t)r * GW + col0;
#pragma unroll
                    for (int bj = 0; bj < 2; ++bj) { const f32x4 v0 = acc[ai][bj][m][0] + bv[bj][0], v1 = acc[ai][bj][m][1] + bv[bj][1];
                        u32x4 w; w.x = cvtpk_c(sigm(v0[0]), sigm(v0[1])); w.y = cvtpk_c(sigm(v0[2]), sigm(v0[3])); w.z = cvtpk_c(sigm(v1[0]), sigm(v1[1])); w.w = cvtpk_c(sigm(v1[2]), sigm(v1[3]));
                        __builtin_nontemporal_store(w, (u32x4*)(rowp + bj * HALF)); }
                }
        }
    }
};
struct EpiRowScale {
    static constexpr bool PERM = true;
    bf16_t* O; int ldc; const float* ssq; int a;
    __device__ __forceinline__ void operator()(const Acc& acc, const Unit& u, int wr, int wc, int fr, int fq) const {
        const int col0 = u.pn * BM + wc * 32 + 8 * fq;
#pragma unroll
        for (int ai = 0; ai < 2; ++ai)
#pragma unroll
            for (int m = 0; m < 4; ++m) {
                const int r = u.pm * BM + ai * HALF + wr * 64 + m * 16 + fr;
                const float rsc = __builtin_amdgcn_rsqf((ssq[(size_t)r * 4 + a] + ssq[(size_t)r * 4 + a + 1]) * (1.f / 512.f) + EPS);
                bf16_t* rowp = O + (size_t)r * ldc + col0;
#pragma unroll
                for (int bj = 0; bj < 2; ++bj) { const f32x4 v0 = acc[ai][bj][m][0] * rsc, v1 = acc[ai][bj][m][1] * rsc;
                    u32x4 w; w.x = cvtpk(v0[0], v0[1]); w.y = cvtpk(v0[2], v0[3]); w.z = cvtpk(v1[0], v1[1]); w.w = cvtpk(v1[2], v1[3]);
                    *(u32x4*)(rowp + bj * HALF) = w; }
            }
    }
};
template <int ACT> struct EpiBf16 {
    static constexpr bool PERM = true;
    bf16_t* O; int ldc;
    __device__ __forceinline__ void operator()(const Acc& acc, const Unit& u, int wr, int wc, int fr, int fq) const {
        const int col0 = u.pn * BM + wc * 32 + 8 * fq;
#pragma unroll
        for (int ai = 0; ai < 2; ++ai)
#pragma unroll
            for (int m = 0; m < 4; ++m) {
                const int r = u.pm * BM + ai * HALF + wr * 64 + m * 16 + fr;
                bf16_t* rowp = O + (size_t)r * ldc + col0;
#pragma unroll
                for (int bj = 0; bj < 2; ++bj) { f32x4 v0 = acc[ai][bj][m][0], v1 = acc[ai][bj][m][1];
                    if (ACT == 1) {
#pragma unroll
                        for (int e = 0; e < 4; ++e) { const float a = fmaxf(v0[e], 0.f), b = fmaxf(v1[e], 0.f); v0[e] = a * a; v1[e] = b * b; } }
                    u32x4 w; w.x = cvtpk(v0[0], v0[1]); w.y = cvtpk(v0[2], v0[3]); w.z = cvtpk(v1[0], v1[1]); w.w = cvtpk(v1[2], v1[3]);
                    *(u32x4*)(rowp + bj * HALF) = w; }
            }
    }
};
struct EpiBranch {
    static constexpr bool PERM = true;
    bf16_t* merged; const bf16_t* gates;
    __device__ __forceinline__ void operator()(const Acc& acc, const Unit& u, int wr, int wc, int fr, int fq) const {
        const int col0 = u.pn * BM + wc * 32 + 8 * fq;
#pragma unroll
        for (int ai = 0; ai < 2; ++ai)
#pragma unroll
            for (int m = 0; m < 4; ++m) {
                const int r = u.pm * BM + ai * HALF + wr * 64 + m * 16 + fr;
                bf16_t* rowp = merged + (size_t)r * D + col0;
                const bf16_t* gp = gates + (size_t)r * GW + u.z * D + col0;
#pragma unroll
                for (int bj = 0; bj < 2; ++bj) { const f32x4 v0 = acc[ai][bj][m][0], v1 = acc[ai][bj][m][1];
                    const u32x4 gw = *(const u32x4*)(gp + bj * HALF);
                    float o[8];
                    o[0] = bflo(gw.x) * v0[0]; o[1] = bfhi(gw.x) * v0[1]; o[2] = bflo(gw.y) * v0[2]; o[3] = bfhi(gw.y) * v0[3];
                    o[4] = bflo(gw.z) * v1[0]; o[5] = bfhi(gw.z) * v1[1]; o[6] = bflo(gw.w) * v1[2]; o[7] = bfhi(gw.w) * v1[3];
                    if (u.z != 0) { const u32x4 pw = *(const u32x4*)(rowp + bj * HALF);
                        o[0] += bflo(pw.x); o[1] += bfhi(pw.x); o[2] += bflo(pw.y); o[3] += bfhi(pw.y); o[4] += bflo(pw.z); o[5] += bfhi(pw.z); o[6] += bflo(pw.w); o[7] += bfhi(pw.w); }
                    u32x4 w; w.x = cvtpk(o[0], o[1]); w.y = cvtpk(o[2], o[3]); w.z = cvtpk(o[4], o[5]); w.w = cvtpk(o[6], o[7]);
                    *(u32x4*)(rowp + bj * HALF) = w; }
            }
    }
};
struct EpiRes {
    static constexpr bool PERM = false;
    const float* base; float* out; const float* modp; const float* ada_b; int layer; int gidx;
    __device__ __forceinline__ void operator()(const Acc& acc, const Unit& u, int wr, int wc, int fr, int fq) const {
        const int col0 = u.pn * BM + wc * 32 + 4 * fq;
        f32x4 gv[2][2];
#pragma unroll
        for (int bj = 0; bj < 2; ++bj)
#pragma unroll
            for (int n = 0; n < 2; ++n)
#pragma unroll
                for (int e = 0; e < 4; ++e) gv[bj][n][e] = mod_at(modp, ada_b, layer, gidx + col0 + bj * HALF + n * 16 + e);
#pragma unroll
        for (int ai = 0; ai < 2; ++ai)
#pragma unroll
            for (int m = 0; m < 4; ++m) {
                const size_t off = (size_t)(u.pm * BM + ai * HALF + wr * 64 + m * 16 + fr) * D + col0;
#pragma unroll
                for (int bj = 0; bj < 2; ++bj)
#pragma unroll
                    for (int n = 0; n < 2; ++n) { const f32x4 bs = *(const f32x4*)(base + off + bj * HALF + n * 16);
                        *(f32x4*)(out + off + bj * HALF + n * 16) = bs + gv[bj][n] * acc[ai][bj][m][n]; }
            }
    }
};
}

namespace att {
constexpr int SHM_V = 16384, SHM_K = 16384, SHM_KR = 8192, BUF = SHM_V + SHM_K + SHM_KR;
constexpr int OFF_BIAS = 2 * BUF;
constexpr int OFF_WS = OFF_BIAS + 3328;
constexpr int OFF_PRE = OFF_WS + 3072;
constexpr int OFF_QS = OFF_PRE + 1280;
constexpr int OFF_QR = OFF_QS + 256;
#define KSWZ(row, colB) ((row) * 256 + ((colB) ^ (((row) & 7) << 4)))
#define SBAR() __builtin_amdgcn_sched_barrier(0)
__device__ __forceinline__ int v_st(int k, int c) { const int kk = (k & ~0xC) | ((k & 4) << 1) | ((k & 8) >> 1); return ((kk >> 3) * 4 + (c >> 5)) * 512 + ((kk & 7) * 32 + (c & 31)) * 2; }
__device__ __forceinline__ int v_rd_base(int lane) { return ((lane & 3) << 3) | (((lane >> 2) & 3) << 6) | (((lane >> 4) & 1) << 5) | (((lane >> 5) & 1) << 8); }
constexpr int v_rd_off(int d0, int ks, int half) { return d0 * 512 + ks * 4096 + half * 2048; }
__device__ __forceinline__ int crow(int r, int hi) { return (r & 3) + 8 * (r >> 2) + 4 * hi; }

struct Unit {
    const bf16_t* Q; const bf16_t* K; const bf16_t* V; bf16_t* O; float* L; const float* btab;
    int qstride, kstride, vstride, kt0, kt1, wmax, bt, neg_next;
};

template <int DQK>
__device__ __forceinline__ void partialSM(f32x16& p0, f32x16& p1, float& m_reg, float& mn, float& alpha) {
    constexpr float SCALE = DQK == 128 ? 0.08838834764831845f : 0.07216878364870322f;
    constexpr float THR = 8.f;
    float pmax = p0[0];
#pragma unroll
    for (int r = 1; r < 16; ++r) pmax = fmaxf(pmax, p0[r]);
#pragma unroll
    for (int r = 0; r < 16; ++r) pmax = fmaxf(pmax, p1[r]);
    { auto rr = __builtin_amdgcn_permlane32_swap(__float_as_uint(pmax), __float_as_uint(pmax), false, false);
      pmax = fmaxf(__uint_as_float(rr[0]), __uint_as_float(rr[1])); }
    constexpr float C2 = 1.4426950408889634f * SCALE;
    if (__builtin_expect(__all((pmax - m_reg) * SCALE <= THR), 1)) { mn = m_reg; alpha = 1.f; }
    else { mn = fmaxf(m_reg, pmax); alpha = __builtin_amdgcn_exp2f((m_reg - mn) * C2); m_reg = mn; }
    const float mnL = -mn * C2;
#pragma unroll
    for (int r = 0; r < 16; ++r) p0[r] = __builtin_amdgcn_exp2f(fmaf(p0[r], C2, mnL));
#pragma unroll
    for (int r = 0; r < 16; ++r) p1[r] = __builtin_amdgcn_exp2f(fmaf(p1[r], C2, mnL));
}
__device__ __forceinline__ void finishSM(f32x16& p0, f32x16& p1, float alpha, float& l_reg, bf16x8& pa0, bf16x8& pa1, bf16x8& pa2, bf16x8& pa3) {
    float ps = 0;
#pragma unroll
    for (int r = 0; r < 16; ++r) ps += p0[r];
#pragma unroll
    for (int r = 0; r < 16; ++r) ps += p1[r];
    { auto rr = __builtin_amdgcn_permlane32_swap(__float_as_uint(ps), __float_as_uint(ps), false, false);
      ps = __uint_as_float(rr[0]) + __uint_as_float(rr[1]); }
    l_reg = l_reg * alpha + ps;
#define PK4(P, B_, OUT) do { unsigned a0 = cvtpk(P[B_+0], P[B_+1]), a1 = cvtpk(P[B_+2], P[B_+3]);                          \
        unsigned b0 = cvtpk(P[B_+4], P[B_+5]), b1 = cvtpk(P[B_+6], P[B_+7]);                                             \
        auto r0 = __builtin_amdgcn_permlane32_swap(a0, b0, false, false); auto r1 = __builtin_amdgcn_permlane32_swap(a1, b1, false, false); \
        u32x4 w = {r0[0], r1[0], r0[1], r1[1]}; OUT = *reinterpret_cast<bf16x8*>(&w); } while (0)
    PK4(p0, 0, pa0); PK4(p0, 8, pa1); PK4(p1, 0, pa2); PK4(p1, 8, pa3);
#undef PK4
}
template <int DQK>
__device__ __forceinline__ void qkt(f32x16& p0, f32x16& p1, const char* buf, const char* qrl, int r32, int hi, const bf16x8* qr) {
    p0 = f32x16{}; p1 = f32x16{};
    const char* K_lds = buf + SHM_V;
    const char* kb[4];
#pragma unroll
    for (int dd = 0; dd < 4; ++dd) kb[dd] = K_lds + KSWZ(r32, (dd * 16 + hi * 8) * 2);
#pragma unroll
    for (int d0 = 0; d0 < 8; ++d0) { const char* a = kb[d0 & 3] + (d0 >> 2) * 128;
        bf16x8 b0 = *reinterpret_cast<const bf16x8*>(a);
        bf16x8 b1 = *reinterpret_cast<const bf16x8*>(a + 32 * 256);
        p0 = __builtin_amdgcn_mfma_f32_32x32x16_bf16(b0, qr[d0], p0, 0, 0, 0);
        p1 = __builtin_amdgcn_mfma_f32_32x32x16_bf16(b1, qr[d0], p1, 0, 0, 0); if ((d0 & 3) == 3) SBAR(); }
    if constexpr (DQK == 192) {
        const char* KR = buf + SHM_V + SHM_K;
#pragma unroll
        for (int d1 = 0; d1 < 4; ++d1) { const char* a = KR + r32 * 128 + (((d1 * 2 + hi) * 16) ^ ((r32 & 7) << 4));
            bf16x8 b0 = *reinterpret_cast<const bf16x8*>(a);
            bf16x8 b1 = *reinterpret_cast<const bf16x8*>(a + 32 * 128);
            const bf16x8 qv = *reinterpret_cast<const bf16x8*>(qrl + r32 * 128 + (((d1 * 2 + hi) * 16) ^ ((r32 & 7) << 4)));
            p0 = __builtin_amdgcn_mfma_f32_32x32x16_bf16(b0, qv, p0, 0, 0, 0);
            p1 = __builtin_amdgcn_mfma_f32_32x32x16_bf16(b1, qv, p1, 0, 0, 0); }
    }
}
__device__ __forceinline__ void pv_tile(f32x16* o, int vb0, bf16x8 pa0, bf16x8 pa1, bf16x8 pa2, bf16x8 pa3) {
#define TRRD(dst, off) asm volatile("ds_read_b64_tr_b16 %0, %1 offset:%2" : "=&v"(dst) : "v"(vb0), "i"(off) : "memory")
#define PV_D0(d0) do { s16x4 l0, l1, l2, l3, h0, h1, h2, h3; constexpr int b_ = v_rd_off(d0, 0, 0); \
        TRRD(l0, b_); TRRD(h0, b_ + 2048); TRRD(l1, b_ + 4096); TRRD(h1, b_ + 6144); TRRD(l2, b_ + 8192); TRRD(h2, b_ + 10240); TRRD(l3, b_ + 12288); TRRD(h3, b_ + 14336); \
        asm volatile("s_waitcnt lgkmcnt(0)" ::: "memory"); SBAR();   \
        o[d0] = __builtin_amdgcn_mfma_f32_32x32x16_bf16(pa0, (bf16x8){l0[0], l0[1], l0[2], l0[3], h0[0], h0[1], h0[2], h0[3]}, o[d0], 0, 0, 0);   \
        o[d0] = __builtin_amdgcn_mfma_f32_32x32x16_bf16(pa1, (bf16x8){l1[0], l1[1], l1[2], l1[3], h1[0], h1[1], h1[2], h1[3]}, o[d0], 0, 0, 0);   \
        o[d0] = __builtin_amdgcn_mfma_f32_32x32x16_bf16(pa2, (bf16x8){l2[0], l2[1], l2[2], l2[3], h2[0], h2[1], h2[2], h2[3]}, o[d0], 0, 0, 0);   \
        o[d0] = __builtin_amdgcn_mfma_f32_32x32x16_bf16(pa3, (bf16x8){l3[0], l3[1], l3[2], l3[3], h3[0], h3[1], h3[2], h3[3]}, o[d0], 0, 0, 0); } while (0)
    PV_D0(0); PV_D0(1); PV_D0(2); PV_D0(3);
#undef PV_D0
#undef TRRD
}

template <int DQK, bool BIAS>
__device__ __forceinline__ void attn_unit(char* lds, LAS unsigned char* ldsl, const Unit& U, int qrow, int qpos, int dst, const int tid) {
    constexpr float SCALE = DQK == 128 ? 0.08838834764831845f : 0.07216878364870322f;
    const int wid = __builtin_amdgcn_readfirstlane(tid >> 6), lane = tid & 63, r32 = lane & 31, hi = lane >> 5;
    bf16x8 qr[8];
    { const bf16_t* qp = U.Q + (size_t)qrow * U.qstride + hi * 8;
#pragma unroll
      for (int d0 = 0; d0 < 8; ++d0) qr[d0] = *(const bf16x8*)(qp + d0 * 16);
      if constexpr (DQK == 192) { char* qrl = lds + OFF_QR + wid * 4096;
#pragma unroll
          for (int d1 = 0; d1 < 4; ++d1) *(bf16x8*)(qrl + r32 * 128 + (((d1 * 2 + hi) * 16) ^ ((r32 & 7) << 4))) = *(const bf16x8*)(qp + 128 + d1 * 16); } }
    float* bt = (float*)(lds + OFF_BIAS);
    if constexpr (BIAS) { for (int i = tid; i < U.bt; i += NT) bt[i] = U.btab[i]; }
    float* ws = (float*)(lds + OFF_WS) + wid * 96; float* li_l = ws; float* al_l = ws + 32; int* ds_l = (int*)(ws + 64);
    if (hi == 0) ds_l[r32] = dst;
    const unsigned offK = (unsigned)(((tid >> 4) * U.kstride + (((tid & 15) ^ ((tid >> 4) & 7)) << 3)) * 2);
    const unsigned offR = (unsigned)(((tid >> 3) * U.kstride + 128 + (((tid & 7) ^ ((tid >> 3) & 7)) << 3)) * 2);
    unsigned offV; { const int kk = ((tid >> 7) << 3) | ((tid & 31) >> 2), k = (kk & ~0xC) | ((kk & 4) << 1) | ((kk & 8) >> 1), c = (((tid >> 5) & 3) << 5) | ((tid & 3) << 3); offV = (unsigned)((k * U.vstride + c) * 2); }
#define GLDS(src, dstl) __builtin_amdgcn_global_load_lds((const unsigned*)(src), (LAS unsigned*)(dstl), 16, 0, 0)
#define DMA(tile, bf) do { const char* kb_ = (const char*)(U.K + (size_t)(tile) * 64 * U.kstride); const char* vb_ = (const char*)(U.V + (size_t)(tile) * 64 * U.vstride); \
        LAS unsigned char* d_ = ldsl + (bf) * BUF + wid * 1024; \
        GLDS(vb_ + offV, d_); GLDS(vb_ + (size_t)64 * U.vstride + offV, d_ + 8192); \
        GLDS(kb_ + offK, d_ + SHM_V); GLDS(kb_ + (size_t)64 * U.kstride + offK, d_ + SHM_V + 8192); \
        if constexpr (DQK == 192) GLDS(kb_ + offR, d_ + SHM_V + SHM_K); } while (0)
    float m_reg = -1e30f, l_reg = 0.f; f32x16 o[4] = {};
    const int nt = U.kt1 - U.kt0;
    DMA(U.kt0, 0); asm volatile("s_waitcnt vmcnt(0)" ::: "memory"); __syncthreads();
    const float NEG = -__builtin_inff();
    for (int t = 0; t < nt; ++t) {
        const int cur = t & 1, kb = (U.kt0 + t) * 64;
        if (t + 1 < nt) DMA(U.kt0 + t + 1, cur ^ 1);
        const bool lane_act = (kb <= qpos) && (qpos - (kb + 63) <= U.wmax);
        if (__any(lane_act)) {
            f32x16 p0, p1;
            qkt<DQK>(p0, p1, lds + cur * BUF, lds + OFF_QR + wid * 4096, r32, hi, qr); SBAR();
            const int dq = qpos - kb - 4 * hi;
            if constexpr (BIAS) {
                const unsigned btm = (unsigned)(U.bt - 1);
                if (__all(qpos - (kb + 63) >= U.bt - 1)) { const float cb = bt[btm];
#pragma unroll
                    for (int r = 0; r < 16; ++r) { p0[r] += cb; p1[r] += cb; } }
                else {
#pragma unroll
                    for (int r = 0; r < 16; ++r) { const int c = (r & 3) + 8 * (r >> 2);
                        unsigned i0 = (unsigned)(dq - c), i1 = (unsigned)(dq - c - 32); i0 = i0 < btm ? i0 : btm; i1 = i1 < btm ? i1 : btm;
                        p0[r] += bt[i0]; p1[r] += bt[i1]; if ((r & 3) == 3) SBAR(); } }
            }
            if (__any((kb + 63 > qpos) || (qpos - kb > U.wmax))) {
                const unsigned W = (unsigned)U.wmax;
#pragma unroll
                for (int r = 0; r < 16; ++r) { const int c = (r & 3) + 8 * (r >> 2);
                    if ((unsigned)(dq - c) > W) p0[r] = NEG;
                    if ((unsigned)(dq - c - 32) > W) p1[r] = NEG; }
            }
            float mn, alpha;
            partialSM<DQK>(p0, p1, m_reg, mn, alpha);
            if (__any(alpha < 1.f)) { if (hi == 0) al_l[r32] = alpha; asm volatile("s_waitcnt lgkmcnt(0)" ::: "memory");
#pragma unroll
                for (int d_ = 0; d_ < 4; ++d_)
#pragma unroll
                    for (int r = 0; r < 16; ++r) o[d_][r] *= al_l[crow(r, hi)]; }
            bf16x8 pa0, pa1, pa2, pa3;
            finishSM(p0, p1, alpha, l_reg, pa0, pa1, pa2, pa3); SBAR();
            const int vb0 = (int)(uintptr_t)(lds + cur * BUF) + v_rd_base(lane);
            pv_tile(o, vb0, pa0, pa1, pa2, pa3);
        }
        asm volatile("s_waitcnt vmcnt(0)" ::: "memory");
        __syncthreads();
    }
#undef DMA
#undef GLDS
    if (hi == 0) li_l[r32] = l_reg;
    if (hi == 0 && dst >= 0) { const float lse = l_reg > 0.f ? m_reg * SCALE + __logf(l_reg) : NEG; U.L[dst] = lse; if (U.neg_next) U.L[dst + 1] = NEG; }
    asm volatile("s_waitcnt lgkmcnt(0)" ::: "memory");
#pragma unroll
    for (int r = 0; r < 16; ++r) { const int orow = crow(r, hi); const float lv = li_l[orow]; const float rl = lv > 0.f ? __builtin_amdgcn_rcpf(lv) : 0.f; const int drow = ds_l[orow];
        bf16_t* orp = U.O + (size_t)(drow >= 0 ? drow : 0) * 128 + r32;
#pragma unroll
        for (int d0 = 0; d0 < 4; ++d0) { const float v = o[d0][r] * rl; const float vn = __shfl_xor(v, 1);
            if ((r32 & 1) == 0 && drow >= 0) *(unsigned*)(orp + d0 * 32) = cvtpk(v, vn); }
        if ((r & 3) == 3) SBAR(); }
}
}

__device__ __forceinline__ unsigned f2bf(float f) { unsigned u = __float_as_uint(f); return (u + 0x7fffu + ((u >> 16) & 1u)) >> 16; }
__device__ __forceinline__ unsigned pk2(float lo, float hi) { return f2bf(lo) | (f2bf(hi) << 16); }
__device__ __forceinline__ void transpose_item(const float* W, int K, int N, bf16_t* WT, int row_off, LAS float* scr, int item, int lane, const float* gk = nullptr) {
    const int nblk = N / 32, kb = item / nblk, nb = item % nblk, k0 = 64 * kb, n0 = 32 * nb;
#pragma unroll 8
    for (int i = 0; i < 32; ++i) { const int kk = 2 * i + (lane >> 5); scr[kk * 33 + (lane & 31)] = __builtin_nontemporal_load(&W[(size_t)(k0 + kk) * N + n0 + (lane & 31)]) * (gk ? gk[k0 + kk] : 1.f); }
    asm volatile("s_waitcnt lgkmcnt(0)" ::: "memory");
    const int c = lane & 7;
#pragma unroll
    for (int j = 0; j < 4; ++j) { const int n = (lane >> 3) + 8 * j; const LAS float* s = scr + (8 * c) * 33 + n;
        u32x4 o; o.x = pk2(s[0 * 33], s[1 * 33]); o.y = pk2(s[2 * 33], s[3 * 33]); o.z = pk2(s[4 * 33], s[5 * 33]); o.w = pk2(s[6 * 33], s[7 * 33]);
        __builtin_nontemporal_store(o, (u32x4*)(WT + (size_t)(row_off + n0 + n) * K + k0 + 8 * c)); }
    asm volatile("s_waitcnt lgkmcnt(0)" ::: "memory");
}

__device__ __forceinline__ void transpose_item_fp8(const float* W, int K, int N, unsigned char* WT, int row_off, LAS float* scr, int item, int lane) {
    const int nblk = N / 32, kb = item / nblk, nb = item % nblk, k0 = 64 * kb, n0 = 32 * nb;
#pragma unroll 8
    for (int i = 0; i < 32; ++i) { const int kk = 2 * i + (lane >> 5); scr[kk * 33 + (lane & 31)] = __builtin_nontemporal_load(&W[(size_t)(k0 + kk) * N + n0 + (lane & 31)]) * 64.f; }
    asm volatile("s_waitcnt lgkmcnt(0)" ::: "memory");
    const int c = lane & 7;
#pragma unroll
    for (int j = 0; j < 4; ++j) { const int n = (lane >> 3) + 8 * j; const LAS float* s = scr + (8 * c) * 33 + n;
        u32x2 o; o.x = pk4_fp8(s[0 * 33], s[1 * 33], s[2 * 33], s[3 * 33]); o.y = pk4_fp8(s[4 * 33], s[5 * 33], s[6 * 33], s[7 * 33]);
        __builtin_nontemporal_store(o, (u32x2*)(WT + (size_t)(row_off + n0 + n) * K + k0 + 8 * c)); }
    asm volatile("s_waitcnt lgkmcnt(0)" ::: "memory");
}

__device__ __forceinline__ void convert_weights(const Params& p, int layer, LAS unsigned char* ldsl) {
    const int tid = otid(), lane = tid & 63, wave = tid >> 6;
    LAS float* scr = (LAS float*)(ldsl + wave * 16384);
    const int gw = obid() * 8 + wave, NGW = gridDim.x * 8;
    unsigned char* wt = p.ws + OFF_WT;
    constexpr int I_IN = 32 * 418, I_GATE = 32 * 192, I_QB = 8 * 48, I_KVB = 8 * 64, I_BR = 16 * 64, I_O = 32 * 64, I_UP = 32 * 256, I_DN = 128 * 64;
    constexpr int NITEMS = I_IN + I_GATE + I_QB + I_KVB + 3 * I_BR + I_O + I_UP + I_DN;
    for (int it = gw; it < NITEMS; it += NGW) {
        int r = it;
        if (r < I_IN) { transpose_item_fp8(p.in[6] + (size_t)layer * D * 13376, D, 13376, wt + WT_IN, 0, scr, r, lane); continue; } r -= I_IN;
        if (r < I_GATE) { transpose_item_fp8(p.in[17] + (size_t)layer * D * GW, D, GW, wt + WT_IN, ZW, scr, r, lane); continue; } r -= I_GATE;
        if (r < I_QB) { transpose_item(p.in[8] + (size_t)layer * 512 * 1536, 512, 1536, (bf16_t*)(wt + WT_QB), 0, scr, r, lane, p.in[7] + layer * 512); continue; } r -= I_QB;
        if (r < I_KVB) { transpose_item(p.in[10] + (size_t)layer * 512 * 2048, 512, 2048, (bf16_t*)(wt + WT_KVB), 0, scr, r, lane, p.in[9] + layer * 512); continue; } r -= I_KVB;
        if (r < I_BR) { transpose_item(p.in[19] + (size_t)layer * 1024 * D, 1024, D, (bf16_t*)(wt + WT_BR), 0, scr, r, lane); continue; } r -= I_BR;
        if (r < I_BR) { transpose_item(p.in[20] + (size_t)layer * 1024 * D, 1024, D, (bf16_t*)(wt + WT_BR), 2048, scr, r, lane); continue; } r -= I_BR;
        if (r < I_BR) { transpose_item(p.in[21] + (size_t)layer * 1024 * D, 1024, D, (bf16_t*)(wt + WT_BR), 4096, scr, r, lane); continue; } r -= I_BR;
        if (r < I_O) { transpose_item(p.in[22] + (size_t)layer * D * D, D, D, (bf16_t*)(wt + WT_O), 0, scr, r, lane); continue; } r -= I_O;
        if (r < I_UP) { transpose_item(p.in[24] + (size_t)layer * D * DFF, D, DFF, (bf16_t*)(wt + WT_UP), 0, scr, r, lane); continue; } r -= I_UP;
        transpose_item(p.in[25] + (size_t)layer * DFF * D, DFF, D, (bf16_t*)(wt + WT_DN), 0, scr, r, lane);
    }
    { u32x4* zp = (u32x4*)(wt + WT_IN + (size_t)13376 * D); const int nz = 192 * D / 16;
      for (int i = obid() * NT + tid; i < nz; i += gridDim.x * NT) zp[i] = (u32x4){0u, 0u, 0u, 0u}; }
}

template <bool FP8OUT>
__device__ __forceinline__ void norm_phase(const Params& p, int layer, const float* xin, const float* gain, int sh_idx, int sc_idx, char* lds) {
    const int tid = otid(), lane = tid & 63, wave = tid >> 6;
    const float* modp = (const float*)(p.ws + OFF_MODP);
    float* gsL = (float*)lds; float* shL = gsL + D;
#pragma unroll
    for (int j = 0; j < 4; ++j) { const int col = tid * 4 + j;
        const float sc = mod_at(modp, p.in[4], layer, sc_idx + col), sh = mod_at(modp, p.in[4], layer, sh_idx + col);
        gsL[col] = gain[layer * D + col] * (1.f + sc); shL[col] = sh; }
    __syncthreads();
    bf16_t* H = (bf16_t*)(p.ws + OFF_H);
    const int gw = obid() * 8 + wave, NGW = gridDim.x * 8;
    for (int m = gw; m < S; m += NGW) {
        const f32x4* xr = (const f32x4*)(xin + (size_t)m * D) + lane;
        f32x4 v[8]; float s = 0.f;
#pragma unroll
        for (int j = 0; j < 8; ++j) { v[j] = xr[64 * j]; s += (v[j].x * v[j].x + v[j].y * v[j].y) + (v[j].z * v[j].z + v[j].w * v[j].w); }
        const float rstd = rsqrtf(wave_sum(s) * (1.f / D) + EPS);
        u32x2* o8 = (u32x2*)(H + (size_t)m * D) + lane; unsigned* o4 = (unsigned*)((unsigned char*)H + (size_t)m * D) + lane;
#pragma unroll
        for (int j = 0; j < 8; ++j) { const f32x4 g4 = *(const f32x4*)(gsL + 4 * lane + 256 * j), s4 = *(const f32x4*)(shL + 4 * lane + 256 * j);
            const f32x4 y = v[j] * rstd * g4 + s4;
            if constexpr (FP8OUT) o4[64 * j] = pk4_fp8(y.x, y.y, y.z, y.w);
            else { u32x2 w; w.x = cvtpk(y.x, y.y); w.y = cvtpk(y.z, y.w); o8[64 * j] = w; } }
    }
    __syncthreads();
}

__device__ __forceinline__ void kbar_phase(const Params& p, char* lds) {
    const int tid = otid();
    const bf16_t* z = (const bf16_t*)(p.ws + OFF_Z);
    float* kbar = (float*)(p.ws + OFF_KBAR);
    float* red = (float*)lds;
    for (int it = obid(); it < 256; it += gridDim.x) {
        const int h = it >> 5, n = it & 31, c = tid & 15, rg = tid >> 4;
        float a[8] = {0, 0, 0, 0, 0, 0, 0, 0};
#pragma unroll
        for (int i = 0; i < 8; ++i) { const u32x4 w = *(const u32x4*)(z + (size_t)(n * 256 + rg * 8 + i) * ZW + ZC_BK + h * 128 + c * 8);
            a[0] += bflo(w.x); a[1] += bfhi(w.x); a[2] += bflo(w.y); a[3] += bfhi(w.y); a[4] += bflo(w.z); a[5] += bfhi(w.z); a[6] += bflo(w.w); a[7] += bfhi(w.w); }
#pragma unroll
        for (int e = 0; e < 8; ++e) red[rg * 128 + c * 8 + e] = a[e];
        __syncthreads();
        if (tid < 128) { float s = 0.f;
#pragma unroll
            for (int g = 0; g < 32; ++g) s += red[g * 128 + tid];
            kbar[(size_t)it * 128 + tid] = s * (1.f / 256.f); }
        __syncthreads();
    }
}

__device__ __forceinline__ void mla_post_phase(const Params& p, int layer) {
    const int tid = otid(), lane = tid & 63, wave = tid >> 6, h = lane >> 3, c8 = lane & 7;
    const bf16_t* z = (const bf16_t*)(p.ws + OFF_Z);
    const bf16_t* qraw = (const bf16_t*)(p.ws + OFF_QRAW); const bf16_t* kvraw = (const bf16_t*)(p.ws + OFF_KVRAW);
    bf16_t* Qc = (bf16_t*)(p.ws + OFF_QC); bf16_t* Kc = (bf16_t*)(p.ws + OFF_KC);
    const int gw = obid() * 8 + wave, NGW = gridDim.x * 8;
    float invf[8];
#pragma unroll
    for (int e = 0; e < 8; ++e) invf[e] = exp2f(-(float)((8 * c8 + e) & 31) * (13.287712379549449f / 32.f)) * 0.15915494309189535f;
    for (int it = gw; it < S * 2; it += NGW) {
        const int t = it >> 1, isk = it & 1;
        const float* gp = (isk ? p.in[16] : p.in[15]) + layer * 192;
        u32x4 w0, w1, w2;
        if (isk) { const bf16_t* kp = kvraw + (size_t)t * 2048 + h * 256; w0 = *(const u32x4*)(kp + 8 * c8); w1 = *(const u32x4*)(kp + 64 + 8 * c8); w2 = *(const u32x4*)(z + (size_t)t * ZW + ZC_KPE + 8 * c8); }
        else { const bf16_t* qp = qraw + (size_t)t * 1536 + h * 192; w0 = *(const u32x4*)(qp + 8 * c8); w1 = *(const u32x4*)(qp + 64 + 8 * c8); w2 = *(const u32x4*)(qp + 128 + 8 * c8); }
        float x0[8], x1[8], x2[8];
        x0[0] = bflo(w0.x); x0[1] = bfhi(w0.x); x0[2] = bflo(w0.y); x0[3] = bfhi(w0.y); x0[4] = bflo(w0.z); x0[5] = bfhi(w0.z); x0[6] = bflo(w0.w); x0[7] = bfhi(w0.w);
        x1[0] = bflo(w1.x); x1[1] = bfhi(w1.x); x1[2] = bflo(w1.y); x1[3] = bfhi(w1.y); x1[4] = bflo(w1.z); x1[5] = bfhi(w1.z); x1[6] = bflo(w1.w); x1[7] = bfhi(w1.w);
        x2[0] = bflo(w2.x); x2[1] = bfhi(w2.x); x2[2] = bflo(w2.y); x2[3] = bfhi(w2.y); x2[4] = bflo(w2.z); x2[5] = bfhi(w2.z); x2[6] = bflo(w2.w); x2[7] = bfhi(w2.w);
        float ss = 0.f;
#pragma unroll
        for (int e = 0; e < 8; ++e) ss += x0[e] * x0[e] + x1[e] * x1[e] + x2[e] * x2[e];
        ss += __shfl_xor(ss, 1); ss += __shfl_xor(ss, 2); ss += __shfl_xor(ss, 4);
        const float r = rsqrtf(ss * (1.f / 192.f) + EPS);
        const f32x4 ga = *(const f32x4*)(gp + 8 * c8), gb = *(const f32x4*)(gp + 8 * c8 + 4), gc = *(const f32x4*)(gp + 64 + 8 * c8), gd = *(const f32x4*)(gp + 64 + 8 * c8 + 4),
                    ge = *(const f32x4*)(gp + 128 + 8 * c8), gf = *(const f32x4*)(gp + 128 + 8 * c8 + 4);
        const float g0[8] = {ga.x, ga.y, ga.z, ga.w, gb.x, gb.y, gb.z, gb.w}, g1[8] = {gc.x, gc.y, gc.z, gc.w, gd.x, gd.y, gd.z, gd.w}, g2[8] = {ge.x, ge.y, ge.z, ge.w, gf.x, gf.y, gf.z, gf.w};
        float y0[8], y1[8], yr[8];
#pragma unroll
        for (int e = 0; e < 8; ++e) { y0[e] = x0[e] * r * g0[e]; y1[e] = x1[e] * r * g1[e];
            const float y2 = x2[e] * r * g2[e], pr = __shfl_xor(y2, 4);
            float rev = (float)t * invf[e]; rev = rev - floorf(rev);
            const float sn = __builtin_amdgcn_sinf(rev), cs = __builtin_amdgcn_cosf(rev);
            yr[e] = (c8 < 4) ? y2 * cs - pr * sn : y2 * cs + pr * sn; }
        bf16_t* op = (isk ? Kc : Qc) + (size_t)t * 1536 + h * 192;
        u32x4 o;
        o.x = cvtpk(y0[0], y0[1]); o.y = cvtpk(y0[2], y0[3]); o.z = cvtpk(y0[4], y0[5]); o.w = cvtpk(y0[6], y0[7]); *(u32x4*)(op + 8 * c8) = o;
        o.x = cvtpk(y1[0], y1[1]); o.y = cvtpk(y1[2], y1[3]); o.z = cvtpk(y1[4], y1[5]); o.w = cvtpk(y1[6], y1[7]); *(u32x4*)(op + 64 + 8 * c8) = o;
        o.x = cvtpk(yr[0], yr[1]); o.y = cvtpk(yr[2], yr[3]); o.z = cvtpk(yr[4], yr[5]); o.w = cvtpk(yr[6], yr[7]); *(u32x4*)(op + 128 + 8 * c8) = o;
    }
}

__device__ __forceinline__ void moba_select_phase(const Params& p, int layer, char* lds) {
    const int tid = otid();
    const bf16_t* z = (const bf16_t*)(p.ws + OFF_Z);
    const float* kbar = (const float*)(p.ws + OFF_KBAR);
    int* cnt = (int*)(p.ws + OFF_CTL) + CW_CNT + layer * 256;
    int* list = (int*)(p.ws + OFF_LIST);
    float* kb = (float*)lds;
    for (int it = obid(); it < 256; it += gridDim.x) {
        const int h = it >> 5, qb = it & 31;
        if (qb > 0) {
            for (int i = tid; i < qb * 128; i += NT) kb[i] = kbar[(size_t)h * 32 * 128 + i];
            __syncthreads();
            {
                const int tok = qb * 256 + (tid >> 1), par = tid & 1;
                u32x4 q[16];
#pragma unroll
                for (int i = 0; i < 16; ++i) q[i] = *(const u32x4*)(z + (size_t)tok * ZW + ZC_BQ + h * 128 + i * 8);
                const float NEGI = -__builtin_inff();
                float b0 = NEGI, b1 = NEGI, b2 = NEGI; int i0 = -1, i1 = -1, i2 = -1;
#define INS3(d, n) do { if (d > b0 || (d == b0 && n < i0)) { b2 = b1; i2 = i1; b1 = b0; i1 = i0; b0 = d; i0 = n; } \
                        else if (d > b1 || (d == b1 && n < i1)) { b2 = b1; i2 = i1; b1 = d; i1 = n; } \
                        else if (d > b2 || (d == b2 && n < i2)) { b2 = d; i2 = n; } } while (0)
                for (int n = par; n < qb; n += 2) {
                    const f32x4* kp = (const f32x4*)(kb + n * 128);
                    float d = 0.f;
#pragma unroll
                    for (int i = 0; i < 16; ++i) { const f32x4 ka = kp[2 * i], kc = kp[2 * i + 1];
                        d += bflo(q[i].x) * ka.x + bfhi(q[i].x) * ka.y + bflo(q[i].y) * ka.z + bfhi(q[i].y) * ka.w + bflo(q[i].z) * kc.x + bfhi(q[i].z) * kc.y + bflo(q[i].w) * kc.z + bfhi(q[i].w) * kc.w; }
                    INS3(d, n);
                }
                const float c0 = __shfl_xor(b0, 1), c1 = __shfl_xor(b1, 1), c2 = __shfl_xor(b2, 1);
                const int j0 = __shfl_xor(i0, 1), j1 = __shfl_xor(i1, 1), j2 = __shfl_xor(i2, 1);
                if (j0 >= 0) INS3(c0, j0);
                if (j1 >= 0) INS3(c1, j1);
                if (j2 >= 0) INS3(c2, j2);
#undef INS3
                if (par == 0) {
                    if (i0 >= 0) { const int s = atomicAdd(&cnt[h * 32 + i0], 1); list[(size_t)(h * 32 + i0) * 8192 + s] = tok * 4 + 0; }
                    if (i1 >= 0) { const int s = atomicAdd(&cnt[h * 32 + i1], 1); list[(size_t)(h * 32 + i1) * 8192 + s] = tok * 4 + 1; }
                    if (i2 >= 0) { const int s = atomicAdd(&cnt[h * 32 + i2], 1); list[(size_t)(h * 32 + i2) * 8192 + s] = tok * 4 + 2; }
                }
            }
            __syncthreads();
        }
    }
}

__device__ __forceinline__ void attention_phase(const Params& p, int layer, char* lds, LAS unsigned char* ldsl) {
    const int tid = otid(), wid = tid >> 6, lane = tid & 63, r32 = lane & 31;
    unsigned char* ws = p.ws;
    const bf16_t* z = (const bf16_t*)(ws + OFF_Z);
    int* ctl = (int*)(ws + OFF_CTL);
    const int* cnt = ctl + CW_CNT + layer * 256;
    int* qctr = ctl + CW_QCTR + layer * 64;
    const int* list = (const int*)(ws + OFF_LIST);
    float* lseA = (float*)(ws + OFF_LSE); float* lseB = (float*)(ws + OFF_LSE + MiB); float* lseC = (float*)(ws + OFF_LSE + 2 * MiB);
    const float* btabA = (const float*)(ws + OFF_BTAB); const float* btabB = btabA + 24 * BTA_STRIDE;
    int* pre = (int*)(lds + att::OFF_PRE);
    if (tid < 256) pre[tid + 1] = (cnt[tid] + 255) >> 8;
    if (tid == 0) pre[0] = 0;
    __syncthreads();
    if (tid == 0) { int s = 0; for (int i = 1; i <= 256; ++i) { s += pre[i]; pre[i] = s; } }
    __syncthreads();
    constexpr int NC = 384, NA = 768, NBO = 256, U_A = NC, U_BO = NC + NA, U_BS = NC + NA + NBO;
    const int total = U_BS + pre[256];
    for (;;) {
        if (tid == 0) *(volatile int*)(lds + att::OFF_QS) = atomicAdd(qctr, 1);
        __syncthreads();
        const int u = __builtin_amdgcn_readfirstlane(*(volatile int*)(lds + att::OFF_QS));
        __syncthreads();
        if (u >= total) break;
        att::Unit U; int qrow, qpos, dst;
        if (u < U_A) {
            int qb, h, half, split;
            if (u < 256) { qb = 31 - (u >> 4); h = (u & 15) >> 1; half = u & 1; split = 1; } else { const int v = u - 256; qb = 15 - (v >> 3); h = v & 7; half = 0; split = 0; }
            const int T = 4 * (qb + 1);
            U.Q = (const bf16_t*)(ws + OFF_QC) + h * 192; U.qstride = 1536; U.K = (const bf16_t*)(ws + OFF_KC) + h * 192; U.kstride = 1536;
            U.V = (const bf16_t*)(ws + OFF_KVRAW) + h * 256 + 128; U.vstride = 2048;
            U.O = (bf16_t*)(ws + OFF_PC); U.L = lseC; U.btab = nullptr; U.bt = 0; U.wmax = 0x7fffffff; U.neg_next = split ? 0 : 1;
            if (split) { U.kt0 = half ? T / 2 : 0; U.kt1 = half ? T : T / 2; } else { U.kt0 = 0; U.kt1 = T; }
            const int tok = qb * 256 + wid * 32 + r32; qrow = tok; qpos = tok; dst = (tok * 8 + h) * 2 + half;
            att::attn_unit<192, false>(lds, ldsl, U, qrow, qpos, dst, tid);
        } else {
            if (u < U_BO) {
                const int a = u - U_A, gh = a >> 5, qblk = a & 31, g = gh >> 3, h = gh & 7, lg = 2 * g, L = S >> lg;
                const int rowbase = qblk * 256, seq0 = rowbase & ~(L - 1), i0 = rowbase - seq0, res = seq0 >> (13 - lg);
                const bf16_t* zb = z + (size_t)seq0 * ZW + g * 1024 + h * 128;
                U.Q = zb + ZC_AQ; U.K = zb + ZC_AK; U.V = zb + ZC_AV; U.qstride = U.kstride = U.vstride = ZW;
                U.O = (bf16_t*)(ws + OFF_PA); U.L = lseA; U.btab = btabA + (g * 8 + h) * BTA_STRIDE; U.bt = BTA; U.wmax = 128; U.neg_next = 0;
                U.kt0 = (i0 >= 128 ? i0 - 128 : 0) >> 6; U.kt1 = (i0 + 256) >> 6;
                qrow = i0 + wid * 32 + r32; qpos = qrow; const int tok = (qrow << lg) + res; dst = (tok * 8 + h) * 3 + g;
            } else if (u < U_BS) {
                const int b = u - U_BO, h = b >> 5, qb = b & 31;
                U.Q = z + ZC_BQ + h * 128; U.K = z + ZC_BK + h * 128; U.V = z + ZC_BV + h * 128; U.qstride = U.kstride = U.vstride = ZW;
                U.O = (bf16_t*)(ws + OFF_PB); U.L = lseB; U.btab = btabB + h * BTB; U.bt = BTB; U.wmax = 0x7fffffff; U.neg_next = 0;
                U.kt0 = qb * 4; U.kt1 = qb * 4 + 4;
                const int tok = qb * 256 + wid * 32 + r32; qrow = tok; qpos = tok; dst = (tok * 8 + h) * 4 + 3;
            } else {
                const int c = u - U_BS; int lo = 0, hi_ = 256;
                while (hi_ - lo > 1) { const int mid = (lo + hi_) >> 1; if (pre[mid] <= c) lo = mid; else hi_ = mid; }
                const int e = lo, h = e >> 5, n = e & 31, chunk = c - pre[e], idx = chunk * 256 + wid * 32 + r32;
                U.Q = z + ZC_BQ + h * 128; U.K = z + ZC_BK + h * 128; U.V = z + ZC_BV + h * 128; U.qstride = U.kstride = U.vstride = ZW;
                U.O = (bf16_t*)(ws + OFF_PB); U.L = lseB; U.btab = btabB + h * BTB; U.bt = BTB; U.wmax = 0x7fffffff; U.neg_next = 0;
                U.kt0 = n * 4; U.kt1 = n * 4 + 4;
                if (idx < cnt[e]) { const int ent = list[(size_t)e * 8192 + idx]; const int tok = ent >> 2; qrow = tok; qpos = tok; dst = (tok * 8 + h) * 4 + (ent & 3); }
                else { qrow = (n + 1) * 256; qpos = qrow; dst = -1; }
            }
            att::attn_unit<128, true>(lds, ldsl, U, qrow, qpos, dst, tid);
        }
    }
}

__device__ __forceinline__ void combine_phase(const Params& p) {
    unsigned char* ws = p.ws;
    const float* lseA = (const float*)(ws + OFF_LSE); const float* lseB = (const float*)(ws + OFF_LSE + MiB); const float* lseC = (const float*)(ws + OFF_LSE + 2 * MiB);
    bf16_t* Y = (bf16_t*)(ws + OFF_Y);
    const int total = S * 3 * 8 * 16;
    for (int i = obid() * NT + otid(); i < total; i += gridDim.x * NT) {
        const int ch = i & 15, h = (i >> 4) & 7, rest = i >> 7, br = rest % 3, t = rest / 3;
        const int np = br == 0 ? 3 : (br == 1 ? 4 : 2);
        const float* lp = br == 0 ? lseA + (size_t)(t * 8 + h) * 3 : (br == 1 ? lseB + (size_t)(t * 8 + h) * 4 : lseC + (size_t)(t * 8 + h) * 2);
        const bf16_t* op = (const bf16_t*)(ws + (br == 0 ? OFF_PA : (br == 1 ? OFF_PB : OFF_PC))) + (size_t)(t * 8 + h) * np * 128 + ch * 8;
        float l[4]; float M = -__builtin_inff();
#pragma unroll
        for (int k = 0; k < 4; ++k) { bool valid = k < np; if (br == 1 && k < 3) valid = k < (t >> 8);
            l[k] = valid ? lp[k < np ? k : 0] : -__builtin_inff(); M = fmaxf(M, l[k]); }
        float acc[8] = {0, 0, 0, 0, 0, 0, 0, 0}; float sum = 0.f;
#pragma unroll
        for (int k = 0; k < 4; ++k) { const float w = __expf(l[k] - M);
            if (l[k] > -3.0e38f && w > 0.f) { sum += w; const u32x4 v = *(const u32x4*)(op + (size_t)k * 128);
                acc[0] += w * bflo(v.x); acc[1] += w * bfhi(v.x); acc[2] += w * bflo(v.y); acc[3] += w * bfhi(v.y); acc[4] += w * bflo(v.z); acc[5] += w * bfhi(v.z); acc[6] += w * bflo(v.w); acc[7] += w * bfhi(v.w); } }
        const float rs = __builtin_amdgcn_rcpf(sum);
        u32x4 w; w.x = cvtpk(acc[0] * rs, acc[1] * rs); w.y = cvtpk(acc[2] * rs, acc[3] * rs); w.z = cvtpk(acc[4] * rs, acc[5] * rs); w.w = cvtpk(acc[6] * rs, acc[7] * rs);
        *(u32x4*)(Y + (size_t)t * 3072 + br * 1024 + h * 128 + ch * 8) = w;
    }
}

#define XB_TMO      128
#define XB_XCNT(j)  (256  + 64 * (j))
#define XB_XSUB(j)  (1280 + 64 * (j))
#define XB_XGEN(j)  (2304 + 64 * (j))
#define XB_TOP      3328
#define XB_TOPGEN   3392
#define XCD_BAR_WORDS 3456
#define XB_SPIN_CAP (1u << 18)

__device__ __forceinline__ unsigned xb_ld(unsigned* p)              { return __hip_atomic_load(p, __ATOMIC_RELAXED, __HIP_MEMORY_SCOPE_AGENT); }
__device__ __forceinline__ unsigned xb_add(unsigned* p, unsigned v) { return __hip_atomic_fetch_add(p, v, __ATOMIC_RELAXED, __HIP_MEMORY_SCOPE_AGENT); }
__device__ __forceinline__ unsigned xb_xcc_id() { return (unsigned)__builtin_amdgcn_s_getreg((3 << 11) | 20) & 0xFu; }
#define XB_SPIN(cond, bar) do { unsigned _sp = 0; while (cond) { __builtin_amdgcn_s_sleep(1); \
    if ((++_sp & 255u) == 0u) { if (xb_ld(&(bar)[XB_TMO])) break; if (_sp > XB_SPIN_CAP) { atomicAdd(&(bar)[XB_TMO], 1u); break; } } } } while (0)

struct XcdBarrier {
    unsigned* bar; unsigned x;
    volatile LAS unsigned* st;
};

__device__ __forceinline__ XcdBarrier xcd_barrier_post(unsigned* bar, volatile LAS unsigned* st) {
    XcdBarrier b; b.bar = bar; b.x = xb_xcc_id(); b.st = st;
    if (otid() == 0) (void)xb_add(&bar[XB_XCNT(b.x)], 1u);
    return b;
}
__device__ __forceinline__ void xcd_barrier_complete(unsigned* bar, unsigned x, unsigned& nloc, unsigned& nx) {
    const unsigned G = gridDim.x * gridDim.y * gridDim.z;
    unsigned sum, cnt, mine, sp = 0u;
    for (;;) {
        sum = 0u; cnt = 0u; mine = 0u;
#pragma unroll
        for (unsigned j = 0; j < 16; ++j) { const unsigned c = xb_ld(&bar[XB_XCNT(j)]); sum += c; cnt += (c > 0u) ? 1u : 0u; mine = (j == x) ? c : mine; }
        if (sum == G) break;
        __builtin_amdgcn_s_sleep(1);
        if ((++sp & 255u) == 0u) { if (xb_ld(&bar[XB_TMO])) break; if (sp > XB_SPIN_CAP) { atomicAdd(&bar[XB_TMO], 1u); break; } }
    }
    nloc = mine > 0u ? mine : 1u; nx = cnt > 0u ? cnt : 1u;
}

__device__ __forceinline__ void xcd_barrier(const XcdBarrier& b) {
    asm volatile("s_waitcnt vmcnt(0)" ::: "memory");
    __syncthreads();
    if (otid() == 0) {
        unsigned* bar = b.bar;
        __builtin_amdgcn_s_waitcnt(0);
        unsigned nloc = b.st[0], nx = b.st[1];
        if (nloc == 0u) { xcd_barrier_complete(bar, b.x, nloc, nx); b.st[0] = nloc; b.st[1] = nx; }
        const unsigned old = xb_add(&bar[XB_XSUB(b.x)], 1u);
        const unsigned gen = old / nloc;
        if (old + 1u == (gen + 1u) * nloc) {
            __builtin_amdgcn_fence(__ATOMIC_RELEASE, "agent");
            asm volatile("s_waitcnt vmcnt(0)" ::: "memory");
            const unsigned og = xb_add(&bar[XB_TOP], 1u);
            const unsigned tg = og / nx;
            if (og + 1u == (tg + 1u) * nx) xb_add(&bar[XB_TOPGEN], 1u);
            else XB_SPIN(xb_ld(&bar[XB_TOPGEN]) == tg, bar);
            __builtin_amdgcn_fence(__ATOMIC_ACQUIRE, "agent");
            xb_add(&bar[XB_XGEN(b.x)], 1u);
            asm volatile("s_waitcnt vmcnt(0)" ::: "memory");
        } else {
            XB_SPIN(xb_ld(&bar[XB_XGEN(b.x)]) == gen, bar);
            __builtin_amdgcn_fence(__ATOMIC_ACQUIRE, "agent");
            asm volatile("s_waitcnt vmcnt(0)" ::: "memory");
        }
    }
    __syncthreads();
}

typedef const __attribute__((address_space(4))) Params* KP;
__device__ __forceinline__ Params ldparams() {
    KP q = (KP)__builtin_amdgcn_kernarg_segment_ptr(); asm volatile("" : "+s"(q));
    Params r;
#pragma unroll
    for (int i = 0; i < 26; ++i) r.in[i] = q->in[i];
    r.out = q->out; r.ws = q->ws; return r;
}

template <int LAYER>
__device__ __forceinline__ void layer_body(const XcdBarrier& xb, char* lds, LAS unsigned char* ldsl) {
    constexpr int layer = LAYER;
    if (layer == 1) { const Params p = ldparams(); convert_weights(p, 1, ldsl); __syncthreads(); }
    { const Params p = ldparams(); norm_phase<true>(p, layer, layer == 0 ? p.in[0] : p.out, p.in[5], 0, 2048, lds); }
    xcd_barrier(xb);
    { const Params p = ldparams(); unsigned char* ws = p.ws;
      pg8::Gemm g{(const bf16_t*)(ws + OFF_H), (const bf16_t*)(ws + OFF_WT + WT_IN), D, D, D, 0, 0};
      pg8::StaticOrder so; so.init(S, NIN, gridDim.x, obid());
      pg8::EpiIn E{(bf16_t*)(ws + OFF_Z), (bf16_t*)(ws + OFF_GATES), p.in[18] + layer * GW, p.in[11] + layer * 128, p.in[12] + layer * 128, p.in[13] + layer * 128, p.in[14] + layer * 128,
                   (float*)(ws + OFF_SSQC), (LAS float*)(ldsl + LDS_XCH)};
      pg8::gemm_phase<pg8::EpiIn, pg8::StaticOrder, true, true>(ldsl, g, so, E); }
    xcd_barrier(xb);
    { const Params p = ldparams(); kbar_phase(p, lds); }
    { const Params p = ldparams(); unsigned char* ws = p.ws;
      pg8::Gemm g{(const bf16_t*)(ws + OFF_Z) + ZC_CQ, (const bf16_t*)(ws + OFF_WT + WT_QB), 512, ZW, 512, 0, 0};
      pg8::StaticOrder so; so.init(S, 1536, gridDim.x, obid());
      pg8::EpiRowScale E{(bf16_t*)(ws + OFF_QRAW), 1536, (const float*)(ws + OFF_SSQC), 0};
      pg8::gemm_phase<pg8::EpiRowScale, pg8::StaticOrder, true>(ldsl, g, so, E); }
    { const Params p = ldparams(); unsigned char* ws = p.ws;
      pg8::Gemm g{(const bf16_t*)(ws + OFF_Z) + ZC_CKV, (const bf16_t*)(ws + OFF_WT + WT_KVB), 512, ZW, 512, 0, 0};
      pg8::StaticOrder so; so.init(S, 2048, gridDim.x, obid());
      pg8::EpiRowScale E{(bf16_t*)(ws + OFF_KVRAW), 2048, (const float*)(ws + OFF_SSQC), 2};
      pg8::gemm_phase<pg8::EpiRowScale, pg8::StaticOrder, true>(ldsl, g, so, E); }
    xcd_barrier(xb);
    { const Params p = ldparams(); mla_post_phase(p, layer); }
    { const Params p = ldparams(); moba_select_phase(p, layer, lds); }
    xcd_barrier(xb);
    { const Params p = ldparams(); attention_phase(p, layer, lds, ldsl); }
    xcd_barrier(xb);
    { const Params p = ldparams(); combine_phase(p); }
    xcd_barrier(xb);
    { const Params p = ldparams(); unsigned char* ws = p.ws;
      pg8::Gemm g{(const bf16_t*)(ws + OFF_Y), (const bf16_t*)(ws + OFF_WT + WT_BR), 1024, 3072, 1024, (size_t)1024 * 2, (size_t)2048 * 1024 * 2};
      pg8::BranchOrder bo{(int)gridDim.x, obid()};
      pg8::EpiBranch E{(bf16_t*)(ws + OFF_MERGED), (const bf16_t*)(ws + OFF_GATES)};
      pg8::gemm_phase<pg8::EpiBranch, pg8::BranchOrder, false>(ldsl, g, bo, E); }
    xcd_barrier(xb);
    { const Params p = ldparams(); unsigned char* ws = p.ws;
      pg8::Gemm g{(const bf16_t*)(ws + OFF_MERGED), (const bf16_t*)(ws + OFF_WT + WT_O), D, D, D, 0, 0};
      pg8::StaticOrder so; so.init(S, D, gridDim.x, obid());
      pg8::EpiRes E{layer == 0 ? p.in[0] : p.out, (float*)(ws + OFF_X1), (const float*)(ws + OFF_MODP), p.in[4], layer, 4096};
      pg8::gemm_phase<pg8::EpiRes, pg8::StaticOrder, false>(ldsl, g, so, E); }
    xcd_barrier(xb);
    { const Params p = ldparams(); norm_phase<false>(p, layer, (const float*)(p.ws + OFF_X1), p.in[23], 6144, 8192, lds); }
    xcd_barrier(xb);
    { const Params p = ldparams(); unsigned char* ws = p.ws;
      pg8::Gemm g{(const bf16_t*)(ws + OFF_H), (const bf16_t*)(ws + OFF_WT + WT_UP), D, D, D, 0, 0};
      pg8::StaticOrder so; so.init(S, DFF, gridDim.x, obid());
      pg8::EpiBf16<1> E{(bf16_t*)(ws + OFF_U), DFF};
      pg8::gemm_phase<pg8::EpiBf16<1>, pg8::StaticOrder, true>(ldsl, g, so, E); }
    xcd_barrier(xb);
    { const Params p = ldparams(); unsigned char* ws = p.ws;
      pg8::Gemm g{(const bf16_t*)(ws + OFF_U), (const bf16_t*)(ws + OFF_WT + WT_DN), DFF, DFF, DFF, 0, 0};
      pg8::StaticOrder so; so.init(S, D, gridDim.x, obid());
      pg8::EpiRes E{(const float*)(ws + OFF_X1), p.out, (const float*)(ws + OFF_MODP), p.in[4], layer, 10240};
      pg8::gemm_phase<pg8::EpiRes, pg8::StaticOrder, false>(ldsl, g, so, E); }
}

__device__ __forceinline__ void prologue_phase(const Params& p, char* lds) {
    const int tid = otid(), bid = obid(), G = gridDim.x;
    unsigned char* ws = p.ws;
    float* modp = (float*)(ws + OFF_MODP);
    if (bid == 0) { int* ctl = (int*)(ws + OFF_CTL); for (int i = tid; i < 4096; i += NT) ctl[i] = 0; }
    { float* btab = (float*)(ws + OFF_BTAB); const float* rel = p.in[2];
      const int nA = 24 * BTA_STRIDE, nB = 8 * BTB;
      for (int i = bid * NT + tid; i < nA + nB; i += G * NT) {
          float v;
          if (i < nA) { const int col = i / BTA_STRIDE, j = i % BTA_STRIDE, g = col >> 3; v = j < BTA ? rel[t5_bucket(j << (2 * g)) * 32 + col] : 0.f; }
          else { const int k = i - nA, h = k / BTB, d = k % BTB; v = rel[t5_bucket(d) * 32 + 24 + h]; }
          btab[i] = v * 11.313708498984761f;
      } }
    { float* cact = (float*)lds;
      for (int i = tid; i < D; i += NT) { const float c = p.in[1][i]; cact[i] = c / (1.f + __expf(-c)); }
      __syncthreads();
      for (int it = bid; it < 2 * KSPLIT * 6; it += G) {
          const int layer = it / (KSPLIT * 6), r = it % (KSPLIT * 6), ks = r / 6, chunk = r % 6, col = chunk * 2048 + tid * 4, k0 = ks * (D / KSPLIT);
          const float* W = p.in[3] + (size_t)layer * D * 12288 + (size_t)k0 * 12288 + col;
          f32x4 acc = {0.f, 0.f, 0.f, 0.f};
#pragma unroll 8
          for (int k = 0; k < D / KSPLIT; ++k) acc += __builtin_nontemporal_load((const f32x4*)(W + (size_t)k * 12288)) * cact[k0 + k];
          *(f32x4*)(modp + (size_t)(layer * KSPLIT + ks) * 12288 + col) = acc;
      }
      __syncthreads(); }
}

__global__ void __launch_bounds__(NT, 2) fwd_megakernel(Params pk) {
    extern __shared__ __attribute__((aligned(16))) unsigned char lds_raw[];
    cg::grid_group grid = cg::this_grid();
    char* lds = (char*)lds_raw; LAS unsigned char* ldsl = (LAS unsigned char*)lds_raw;
    (void)pk;
    if (threadIdx.x < 2) ((volatile LAS unsigned*)(ldsl + LDS_MISC))[threadIdx.x] = 0u;
    if ((threadIdx.x & 63) == 0) ((volatile LAS int*)(ldsl + LDS_WTAB))[__builtin_amdgcn_s_getreg((5 << 11) | 4) & 63u] = (int)(threadIdx.x >> 6);
    __syncthreads();
    XcdBarrier xb;
    { const Params p = ldparams(); xb = xcd_barrier_post((unsigned*)(p.ws + OFF_CTL) + CW_BAR, (volatile LAS unsigned*)(ldsl + LDS_MISC));
      if (p.ws == nullptr) grid.sync(); }
    { const Params p = ldparams(); prologue_phase(p, lds); }
    { const Params p = ldparams(); convert_weights(p, 0, ldsl); }
    xcd_barrier(xb);
    layer_body<0>(xb, lds, ldsl);
    xcd_barrier(xb);
    layer_body<1>(xb, lds, ldsl);
}

extern "C" void kernel_launch(void* const* d_in, const int* in_sizes, int n_in, void* d_out, int out_size, void* d_ws, size_t ws_size, hipStream_t stream) {
    static int grid_blocks = 0;
    if (grid_blocks == 0) {
        if (n_in != 26 || ws_size < WS_END) { fprintf(stderr, "kernel_launch: unexpected n_in %d or ws_size %zu (< %zu)\n", n_in, ws_size, (size_t)WS_END); grid_blocks = -1; return; }
        int dev = 0, cus = 0, per_cu = 0;
        (void)hipGetDevice(&dev);
        (void)hipDeviceGetAttribute(&cus, hipDeviceAttributeMultiprocessorCount, dev);
        if (hipFuncSetAttribute((const void*)fwd_megakernel, hipFuncAttributeMaxDynamicSharedMemorySize, LDS_BYTES) != hipSuccess) { fprintf(stderr, "kernel_launch: hipFuncSetAttribute failed\n"); grid_blocks = -1; return; }
        if (hipOccupancyMaxActiveBlocksPerMultiprocessor(&per_cu, (const void*)fwd_megakernel, NT, LDS_BYTES) != hipSuccess || per_cu < 1) { fprintf(stderr, "kernel_launch: occupancy query gave %d\n", per_cu); per_cu = 1; }
        (void)hipGetLastError();
        if (cus <= 0) cus = 256;
        grid_blocks = cus * (per_cu > 1 ? 1 : per_cu);
    }
    if (grid_blocks < 0) return;
    if (hipMemsetAsync((char*)d_ws + OFF_CTL + (size_t)CW_BAR * 4, 0, (size_t)XCD_BAR_WORDS * 4, stream) != hipSuccess) { fprintf(stderr, "kernel_launch: memset of the barrier words failed\n"); return; }
    Params p{};
    for (int i = 0; i < 26; ++i) p.in[i] = (const float*)d_in[i];
    p.out = (float*)d_out; p.ws = (unsigned char*)d_ws;
    void* args[] = {&p};
    hipError_t e = hipLaunchCooperativeKernel((const void*)fwd_megakernel, dim3(grid_blocks), dim3(NT), args, LDS_BYTES, stream);
    if (e != hipSuccess) fprintf(stderr, "cooperative launch failed: %s (grid %d)\n", hipGetErrorString(e), grid_blocks);
}
```

```cpp
#include <hip/hip_runtime.h>
#include <hip/hip_bf16.h>
#include <hip/hip_cooperative_groups.h>
#include <cstdio>
#include <cstdint>
namespace cg = cooperative_groups;

#define LAS __attribute__((address_space(3)))
typedef unsigned short bf16_t;
typedef short bf16x8 __attribute__((ext_vector_type(8)));
typedef short s16x4 __attribute__((ext_vector_type(4)));
typedef float f32x4 __attribute__((ext_vector_type(4)));
typedef float f32x2 __attribute__((ext_vector_type(2)));
typedef float f32x16 __attribute__((ext_vector_type(16)));
typedef unsigned u32x4 __attribute__((ext_vector_type(4)));
typedef unsigned u32x2 __attribute__((ext_vector_type(2)));
typedef int v4i __attribute__((ext_vector_type(4)));
typedef int v8i __attribute__((ext_vector_type(8)));

constexpr int S = 8192, D = 2048, DFF = 8192;
constexpr int ZW = 13568;
constexpr int GW = 6144;
constexpr int NIN = ZW + GW;
constexpr int ZC_AQ = 0, ZC_AK = 3072, ZC_AV = 6144, ZC_BQ = 9216, ZC_BK = 10240, ZC_BV = 11264, ZC_CQ = 12288, ZC_CKV = 12800, ZC_KPE = 13312;
constexpr float EPS = 1e-6f;
constexpr int NT = 512;
constexpr int KSPLIT = 16;
constexpr int BTA = 129, BTA_STRIDE = 132, BTB = 800;

constexpr size_t MiB = 1u << 20;
constexpr size_t OFF_CTL = 0;
constexpr size_t OFF_MODP = 1 * MiB;
constexpr size_t OFF_BTAB = 3 * MiB;
constexpr size_t OFF_KBAR = 4 * MiB;
constexpr size_t OFF_LIST = 5 * MiB;
constexpr size_t OFF_LSE = 13 * MiB;
constexpr size_t OFF_WT = 16 * MiB;
constexpr size_t WT_IN = 0, WT_QB = 77 * MiB, WT_KVB = WT_QB + 3 * MiB / 2, WT_BR = WT_KVB + 2 * MiB, WT_O = WT_BR + 12 * MiB, WT_UP = WT_O + 8 * MiB, WT_DN = WT_UP + 32 * MiB;
constexpr size_t OFF_Z = OFF_WT + 165 * MiB;
constexpr size_t OFF_U = OFF_Z, OFF_Y = OFF_Z + 128 * MiB, OFF_MERGED = OFF_Z + 176 * MiB;
constexpr size_t OFF_GATES = OFF_Z + 212 * MiB;
constexpr size_t OFF_H = OFF_GATES + 96 * MiB;
constexpr size_t OFF_QRAW = OFF_H + 32 * MiB;
constexpr size_t OFF_KVRAW = OFF_QRAW + 24 * MiB;
constexpr size_t OFF_QC = OFF_KVRAW + 32 * MiB;
constexpr size_t OFF_KC = OFF_QC + 24 * MiB;
constexpr size_t OFF_PA = OFF_KC + 24 * MiB;
constexpr size_t OFF_PB = OFF_PA + 48 * MiB;
constexpr size_t OFF_PC = OFF_PB + 64 * MiB;
constexpr size_t OFF_X1 = OFF_PC + 32 * MiB;
constexpr size_t WS_END = OFF_X1 + 64 * MiB;
static_assert(WT_DN + 32 * MiB <= 165 * MiB, "weights");
constexpr int CW_CNT = 0;
constexpr int CW_QCTR = 1024;
constexpr int CW_BAR = 4096;
constexpr int LDS_MISC = 135168;
constexpr int LDS_XCH = 136192;
constexpr size_t OFF_SSQC = OFF_KBAR + 512 * 1024;

constexpr int LDS_BYTES = 147456;

struct Params { const float* in[26]; float* out; unsigned char* ws; };

constexpr int LDS_WTAB = 135168 + 64;
__device__ __forceinline__ int otid() {
    extern __shared__ __attribute__((aligned(16))) unsigned char lds_raw[];
    const unsigned hw = __builtin_amdgcn_s_getreg((5 << 11) | 4) & 63u;
    const int wid = ((const volatile LAS int*)((LAS unsigned char*)lds_raw + LDS_WTAB))[hw];
    int t = __builtin_amdgcn_readfirstlane(wid) * 64 + (int)__builtin_amdgcn_mbcnt_hi(~0u, __builtin_amdgcn_mbcnt_lo(~0u, 0u));
    asm volatile("" : "+v"(t)); return t; }
__device__ __forceinline__ int obid() { int b = blockIdx.x; asm volatile("" : "+s"(b)); return b; }
typedef __bf16 bf16v2 __attribute__((ext_vector_type(2)));
__device__ __forceinline__ unsigned cvtpk(float lo, float hi) { f32x2 v = {lo, hi}; bf16v2 b = __builtin_convertvector(v, bf16v2); return __builtin_bit_cast(unsigned, b); }
__device__ __forceinline__ unsigned cvtpk_c(float lo, float hi) { f32x2 v = {lo, hi}; bf16v2 b = __builtin_convertvector(v, bf16v2); return __builtin_bit_cast(unsigned, b); }
__device__ __forceinline__ unsigned pk4_fp8(float a, float b, float c, float d) { int v = 0; v = __builtin_amdgcn_cvt_pk_fp8_f32(a, b, v, false); v = __builtin_amdgcn_cvt_pk_fp8_f32(c, d, v, true); return (unsigned)v; }
__device__ __forceinline__ float bf2f(unsigned short h) { return __uint_as_float(((unsigned)h) << 16); }
__device__ __forceinline__ float bflo(unsigned w) { return __uint_as_float(w << 16); }
__device__ __forceinline__ float bfhi(unsigned w) { return __uint_as_float(w & 0xffff0000u); }
__device__ __forceinline__ float wave_sum(float v) {
#pragma unroll
    for (int o = 1; o < 64; o <<= 1) v += __shfl_xor(v, o);
    return v;
}
__device__ __forceinline__ float mod_at(const float* modp, const float* ada_b, int layer, int idx) {
    float s = ada_b[layer * 12288 + idx];
#pragma unroll
    for (int ks = 0; ks < KSPLIT; ++ks) s += modp[(size_t)(layer * KSPLIT + ks) * 12288 + idx];
    return s;
}
__device__ __forceinline__ int t5_bucket(int n) {
    if (n < 16) return n;
    const float nf = (float)n;
    int large = 16 + (int)(logf(nf / 16.f) / 4.1588830833596715f * 16.f);
    return large < 31 ? large : 31;
}

namespace pg8 {
constexpr int BM = 256, BK = 64, HALF = 128, HTB = HALF * BK * 2, STAGE_BYTES = 8 * HTB, NXCD = 8, WGM = 8;
__host__ __device__ __forceinline__ int lds_byte(int r, int c) { const int st = (r >> 4) * 2 + (c >> 5), rr = r & 15, cc = c & 31, ob = rr * 64 + cc * 2; return st * 1024 + (ob ^ (((ob >> 9) & 1) << 5)); }
__host__ __device__ __forceinline__ void stage_rc(int b, int& R, int& C) { const int st = b / 1024, sb = b % 1024, swz = sb ^ (((sb >> 9) & 1) << 5); R = (st >> 1) * 16 + swz / 64; C = (st & 1) * 32 + (swz % 64) / 2; }
__host__ __device__ __forceinline__ int perm32(int rho) { const int n = rho >> 4, i = rho & 15; return 8 * (i >> 2) + 4 * n + (i & 3); }

struct Unit { int pm, pn, z; };
struct Gemm { const bf16_t* A; const bf16_t* Bt; int K; int lda, ldb; size_t zA, zB; };

struct StaticOrder {
    int nM, nN, nwg, G, c;
    __device__ void init(int M, int N, int G_, int c_) { nM = M / BM; nN = N / BM; nwg = nM * nN; G = G_; c = c_; }
    __device__ bool next(int i, Unit& u) const {
        const long L = (long)i * G + c; if (L >= nwg) return false;
        int wgid = (int)L; { const int q = nwg / NXCD, r = nwg % NXCD, xcd = wgid % NXCD, off = wgid / NXCD; wgid = (xcd < r ? xcd * (q + 1) : r * (q + 1) + (xcd - r) * q) + off; }
        const int nig = WGM * nN, gid = wgid / nig, fm = gid * WGM, gsz = (nM - fm) < WGM ? (nM - fm) : WGM;
        u.pm = fm + ((wgid % nig) % gsz); u.pn = (wgid % nig) / gsz; u.z = 0; return true;
    }
};
struct BranchOrder {
    int G, c;
    __device__ bool next(int i, Unit& u) const { const int tile = c + (i / 3) * G; if (tile >= 256) return false; u.pm = tile >> 3; u.pn = tile & 7; u.z = i % 3; return true; }
};

template <bool FP8> struct FragT { struct T { bf16x8 k[2]; }; };
template <> struct FragT<true> { struct T { v8i v; }; };
__device__ __forceinline__ void ldfrag(FragT<false>::T& f, const LAS unsigned char* p) { f.k[0] = *(const LAS bf16x8*)p; f.k[1] = *(const LAS bf16x8*)(p + 1024); }
__device__ __forceinline__ void ldfrag(FragT<true>::T& f, const LAS unsigned char* p) { f.v = *(const LAS v8i*)p; }
__device__ __forceinline__ void mma1(f32x4& c, const FragT<false>::T& a, const FragT<false>::T& b) {
    c = __builtin_amdgcn_mfma_f32_16x16x32_bf16(a.k[0], b.k[0], c, 0, 0, 0); c = __builtin_amdgcn_mfma_f32_16x16x32_bf16(a.k[1], b.k[1], c, 0, 0, 0); }
__device__ __forceinline__ void mma1(f32x4& c, const FragT<true>::T& a, const FragT<true>::T& b) {
#if defined(__HIP_DEVICE_COMPILE__)
    const int sa = 0x79797979, sb = 0x7F7F7F7F;
    asm volatile("s_nop 1\n\tv_mfma_scale_f32_16x16x128_f8f6f4 %0, %1, %2, %0, %3, %4 op_sel_hi:[0,0,0]" : "+v"(c) : "v"(a.v), "v"(b.v), "v"(sa), "v"(sb));
#endif
}
template <class Epi, class Sched, bool ALIGN_EPI, bool FP8 = false>
__device__ __forceinline__ void gemm_phase(LAS unsigned char* lds, const Gemm g, const Sched& S, const Epi& E) {
    const int tid = otid(), wid = __builtin_amdgcn_readfirstlane(tid >> 6), lane = tid & 63, wr = wid >> 2, wc = wid & 3, fr = lane & 15, fq = lane >> 4;
    constexpr int ES = FP8 ? 1 : 2;
    const int K = g.K, nt = K * ES / 128;
    unsigned voffA[2], voffB[2];
#pragma unroll
    for (int i = 0; i < 2; ++i) { int R, C; stage_rc(tid * 16 + i * 8192, R, C); const int Rb = Epi::PERM ? ((R & ~31) + perm32(R & 31)) : R;
        voffA[i] = (unsigned)(R * g.lda * ES + C * 2); voffB[i] = (unsigned)(Rb * g.ldb * ES + C * 2); }
    const size_t kstep = (size_t)(BK * 2);
    const size_t hstepA = (size_t)HALF * g.lda * ES, hstepB = (size_t)HALF * g.ldb * ES;
    const size_t tstepA = 2 * hstepA, tstepB = 2 * hstepB;
    const unsigned ldsw = (unsigned)wid * 1024u;
    const int aoff = FP8 ? lds_byte(wr * 64 + fr, ((2 * fq) & 3) * 8) + (fq >> 1) * 1024 : lds_byte(wr * 64 + fr, fq * 8);
    const int boff = FP8 ? lds_byte(wc * 32 + fr, ((2 * fq) & 3) * 8) + (fq >> 1) * 1024 : lds_byte(wc * 32 + fr, fq * 8);
#define PG8_SA(b, h) (((b) * 2 + (h)) * HTB)
#define PG8_SB(b, h) ((4 + (b) * 2 + (h)) * HTB)
#define PG8_STAGE(bufoff, gbase, voff) do { _Pragma("unroll") for (int _i = 0; _i < 2; ++_i) \
        __builtin_amdgcn_global_load_lds((const unsigned*)((const char*)(gbase) + (voff)[_i]), (LAS unsigned*)(lds + (bufoff) + ldsw + _i * 8192), 16, 0, 0); } while (0)
#define PG8_LDA(dst, b, h) do { _Pragma("unroll") for (int m = 0; m < 4; ++m) ldfrag(dst[m], lds + PG8_SA(b, h) + aoff + m * 2048); } while (0)
#define PG8_LDB(dst, b, h) do { _Pragma("unroll") for (int n = 0; n < 2; ++n) ldfrag(dst[n], lds + PG8_SB(b, h) + boff + n * 2048); } while (0)
#define PG8_MMA(ai, bj, At, Bt) do { __builtin_amdgcn_s_setprio(1); _Pragma("unroll") for (int m = 0; m < 4; ++m) _Pragma("unroll") for (int n = 0; n < 2; ++n) mma1(acc[ai][bj][m][n], Bt[n], At[m]); __builtin_amdgcn_s_setprio(0); } while (0)
#define PG8_WAIT_V(n) asm volatile("s_waitcnt vmcnt(" #n ")" ::: "memory")
#define PG8_WAIT_L(n) asm volatile("s_waitcnt lgkmcnt(" #n ")" ::: "memory")
#define PG8_BAR __builtin_amdgcn_s_barrier()
#define PG8_SCHED __builtin_amdgcn_sched_barrier(0)
    Unit cur, nxt; int ui = 0;
    if (!S.next(0, cur)) return;
    f32x4 acc[2][2][4][2];
#pragma unroll
    for (int a = 0; a < 2; ++a)
#pragma unroll
        for (int b = 0; b < 2; ++b)
#pragma unroll
            for (int m = 0; m < 4; ++m)
#pragma unroll
                for (int n = 0; n < 2; ++n) acc[a][b][m][n] = (f32x4){0.f, 0.f, 0.f, 0.f};
    typedef typename FragT<FP8>::T Frag;
    Frag At[4], B0[2], B1[2];
    const char* cA = (const char*)g.A + (size_t)cur.pm * tstepA + (size_t)cur.z * g.zA; const char* cB = (const char*)g.Bt + (size_t)cur.pn * tstepB + (size_t)cur.z * g.zB;
    PG8_STAGE(PG8_SB(0, 0), cB, voffB); PG8_STAGE(PG8_SB(0, 1), cB + hstepB, voffB); PG8_STAGE(PG8_SA(0, 0), cA, voffA); PG8_STAGE(PG8_SA(0, 1), cA + hstepA, voffA);
    if (wr == 1) PG8_BAR;
    PG8_WAIT_V(2); PG8_BAR;
    PG8_STAGE(PG8_SB(1, 0), cB + kstep, voffB); PG8_STAGE(PG8_SA(1, 0), cA + kstep, voffA); PG8_STAGE(PG8_SB(1, 1), cB + hstepB + kstep, voffB);
    PG8_WAIT_V(6); PG8_BAR;
    for (;;) {
        const bool has_next = S.next(ui + 1, nxt);
        const char* nA = has_next ? (const char*)g.A + (size_t)nxt.pm * tstepA + (size_t)nxt.z * g.zA : cA; const char* nB = has_next ? (const char*)g.Bt + (size_t)nxt.pn * tstepB + (size_t)nxt.z * g.zB : cB;
        for (int t = 0; t < nt; t += 2) {
            const bool last = (t == nt - 2);
            const char* a1 = cA + (size_t)(t + 1) * kstep;
            const char* a2 = last ? nA : cA + (size_t)(t + 2) * kstep; const char* b2 = last ? nB : cB + (size_t)(t + 2) * kstep;
            const char* a3 = a2 + kstep; const char* b3 = b2 + kstep;
            PG8_LDB(B0, 0, 0); PG8_LDB(B1, 0, 1); PG8_SCHED; PG8_LDA(At, 0, 0); PG8_STAGE(PG8_SA(1, 1), a1 + hstepA, voffA);
            PG8_WAIT_V(8); PG8_WAIT_L(0); PG8_BAR; PG8_MMA(0, 0, At, B0); PG8_MMA(0, 1, At, B1); PG8_BAR; PG8_SCHED;
            PG8_LDA(At, 0, 1); PG8_STAGE(PG8_SB(0, 0), b2, voffB); PG8_STAGE(PG8_SB(0, 1), b2 + hstepB, voffB); PG8_STAGE(PG8_SA(0, 0), a2, voffA);
            PG8_WAIT_V(8); PG8_WAIT_L(0); PG8_BAR; PG8_MMA(1, 0, At, B0); PG8_MMA(1, 1, At, B1); PG8_BAR; PG8_SCHED;
            PG8_LDB(B0, 1, 0); PG8_LDB(B1, 1, 1); PG8_SCHED; PG8_LDA(At, 1, 0); PG8_STAGE(PG8_SA(0, 1), a2 + hstepA, voffA);
            PG8_WAIT_V(8); PG8_WAIT_L(0); PG8_BAR; PG8_MMA(0, 0, At, B0); PG8_MMA(0, 1, At, B1); PG8_BAR; PG8_SCHED;
            PG8_LDA(At, 1, 1); PG8_STAGE(PG8_SB(1, 0), b3, voffB); PG8_STAGE(PG8_SB(1, 1), b3 + hstepB, voffB); PG8_STAGE(PG8_SA(1, 0), a3, voffA);
            PG8_WAIT_V(8); PG8_WAIT_L(0); PG8_BAR; PG8_MMA(1, 0, At, B0); PG8_MMA(1, 1, At, B1); PG8_BAR; PG8_SCHED;
        }
        if constexpr (ALIGN_EPI) { if (wr == 0) PG8_BAR; }
        if constexpr (FP8) asm volatile("s_nop 15\n\ts_nop 15\n\ts_nop 7" ::: "memory");
        E(acc, cur, wr, wc, fr, fq);
        if (!has_next) break;
#pragma unroll
        for (int a = 0; a < 2; ++a)
#pragma unroll
            for (int b = 0; b < 2; ++b)
#pragma unroll
                for (int m = 0; m < 4; ++m)
#pragma unroll
                    for (int n = 0; n < 2; ++n) acc[a][b][m][n] = (f32x4){0.f, 0.f, 0.f, 0.f};
        cur = nxt; cA = nA; cB = nB; ++ui;
        if constexpr (ALIGN_EPI) { if (wr == 1) PG8_BAR; }
    }
    PG8_WAIT_V(0);
    if constexpr (!ALIGN_EPI) { if (wr == 0) PG8_BAR; }
    PG8_BAR;
#undef PG8_SA
#undef PG8_SB
#undef PG8_STAGE
#undef PG8_LDA
#undef PG8_LDB
#undef PG8_MMA
#undef PG8_WAIT_V
#undef PG8_WAIT_L
#undef PG8_BAR
#undef PG8_SCHED
}

typedef f32x4 Acc[2][2][4][2];
__device__ __forceinline__ float sigm(float x) { return __builtin_amdgcn_rcpf(1.f + __builtin_amdgcn_exp2f(x * -1.4426950408889634f)); }

struct EpiIn {
    static constexpr bool PERM = true;
    bf16_t* z; bf16_t* gates; const float* b_gate; const float* qn_a; const float* kn_a; const float* qn_b; const float* kn_b; float* ssqC; LAS float* xch;
    __device__ __forceinline__ void operator()(const Acc& acc, const Unit& u, int wr, int wc, int fr, int fq) const {
        const int colt = u.pn * BM;
        if (colt < ZW) {
            int lg = 0; if (colt < 9216) { const int gi = (colt % 3072) >> 10; lg = 2 * gi; }
            const float* gain = nullptr;
            if (colt < 3072) gain = qn_a; else if (colt < 6144) gain = kn_a; else if (colt >= ZC_BQ && colt < ZC_BK) gain = qn_b; else if (colt >= ZC_BK && colt < ZC_BV) gain = kn_b;
            const bool isC = colt >= ZC_CQ && colt < ZC_KPE;
            const int col0 = colt + wc * 32 + 8 * fq;
            float rs[2][4][2];
            f32x4 g0 = {1.f, 1.f, 1.f, 1.f}, g1 = g0;
            if (gain != nullptr || isC) {
#pragma unroll
                for (int ai = 0; ai < 2; ++ai)
#pragma unroll
                    for (int m = 0; m < 4; ++m)
#pragma unroll
                        for (int bj = 0; bj < 2; ++bj) { const f32x4 a = acc[ai][bj][m][0], b = acc[ai][bj][m][1];
                            float s = (a[0] * a[0] + a[1] * a[1]) + (a[2] * a[2] + a[3] * a[3]) + (b[0] * b[0] + b[1] * b[1]) + (b[2] * b[2] + b[3] * b[3]);
                            s += __shfl_xor(s, 16); s += __shfl_xor(s, 32);
                            if (fq == 0) xch[((ai * HALF + wr * 64 + m * 16 + fr) * 2 + bj) * 4 + wc] = s; }
                asm volatile("s_waitcnt lgkmcnt(0)" ::: "memory"); __builtin_amdgcn_s_barrier(); asm volatile("" ::: "memory");
#pragma unroll
                for (int ai = 0; ai < 2; ++ai)
#pragma unroll
                    for (int m = 0; m < 4; ++m) { const int rl = ai * HALF + wr * 64 + m * 16 + fr;
                        const f32x4 t0 = *(const LAS f32x4*)(xch + (rl * 2 + 0) * 4), t1 = *(const LAS f32x4*)(xch + (rl * 2 + 1) * 4);
                        const float s0 = (t0[0] + t0[1]) + (t0[2] + t0[3]), s1 = (t1[0] + t1[1]) + (t1[2] + t1[3]);
                        if (gain != nullptr) { rs[ai][m][0] = __builtin_amdgcn_rsqf(s0 * (1.f / 128.f) + EPS); rs[ai][m][1] = __builtin_amdgcn_rsqf(s1 * (1.f / 128.f) + EPS); }
                        else { rs[ai][m][0] = 1.f; rs[ai][m][1] = 1.f; if (wc == 0 && fq == 0) ssqC[(size_t)(u.pm * BM + rl) * 4 + ((colt - ZC_CQ) >> 8)] = s0 + s1; } }
                if (gain != nullptr) { g0 = *(const f32x4*)(gain + wc * 32 + 8 * fq); g1 = *(const f32x4*)(gain + wc * 32 + 8 * fq + 4); }
            } else {
#pragma unroll
                for (int ai = 0; ai < 2; ++ai)
#pragma unroll
                    for (int m = 0; m < 4; ++m) { rs[ai][m][0] = 1.f; rs[ai][m][1] = 1.f; }
            }
#pragma unroll
            for (int ai = 0; ai < 2; ++ai)
#pragma unroll
                for (int m = 0; m < 4; ++m) {
                    const int r = u.pm * BM + ai * HALF + wr * 64 + m * 16 + fr;
                    const int zr = ((r & ((1 << lg) - 1)) << (13 - lg)) + (r >> lg);
                    bf16_t* rowp = z + (size_t)zr * ZW + col0;
#pragma unroll
                    for (int bj = 0; bj < 2; ++bj) { const f32x4 v0 = acc[ai][bj][m][0] * rs[ai][m][bj] * g0, v1 = acc[ai][bj][m][1] * rs[ai][m][bj] * g1;
                        u32x4 w; w.x = cvtpk(v0[0], v0[1]); w.y = cvtpk(v0[2], v0[3]); w.z = cvtpk(v1[0], v1[1]); w.w = cvtpk(v1[2], v1[3]);
                        *(u32x4*)(rowp + bj * HALF) = w; }
                }
        } else {
            const int col0 = colt - ZW + wc * 32 + 8 * fq;
            f32x4 bv[2][2];
#pragma unroll
            for (int bj = 0; bj < 2; ++bj)
#pragma unroll
                for (int n = 0; n < 2; ++n) bv[bj][n] = *(const f32x4*)(b_gate + col0 + bj * HALF + 4 * n);
#pragma unroll
            for (int ai = 0; ai < 2; ++ai)
#pragma unroll
                for (int m = 0; m < 4; ++m) {
                    const int r = u.pm * BM + ai * HALF + wr * 64 + m * 16 + fr;
                    bf16_t* rowp = gates + (size_t)r * GW + col0;
#pragma unroll
                    for (int bj = 0; bj < 2; ++bj) { const f32x4 v0 = acc[ai][bj][m][0] + bv[bj][0], v1 = acc[ai][bj][m][1] + bv[bj][1];
                        u32x4 w; w.x = cvtpk_c(sigm(v0[0]), sigm(v0[1])); w.y = cvtpk_c(sigm(v0[2]), sigm(v0[3])); w.z = cvtpk_c(sigm(v1[0]), sigm(v1[1])); w.w = cvtpk_c(sigm(v1[2]), sigm(v1[3]));
                        *(u32x4*)(rowp + bj * HALF) = w; }
                }
        }
    }
};
struct EpiRowScale {
    static constexpr bool PERM = true;
    bf16_t* O; int ldc; const float* ssq; int a;
    __device__ __forceinline__ void operator()(const Acc& acc, const Unit& u, int wr, int wc, int fr, int fq) const {
        const int col0 = u.pn * BM + wc * 32 + 8 * fq;
#pragma unroll
        for (int ai = 0; ai < 2; ++ai)
#pragma unroll
            for (int m = 0; m < 4; ++m) {
                const int r = u.pm * BM + ai * HALF + wr * 64 + m * 16 + fr;
                const float rsc = __builtin_amdgcn_rsqf((ssq[(size_t)r * 4 + a] + ssq[(size_t)r * 4 + a + 1]) * (1.f / 512.f) + EPS);
                bf16_t* rowp = O + (size_t)r * ldc + col0;
#pragma unroll
                for (int bj = 0; bj < 2; ++bj) { const f32x4 v0 = acc[ai][bj][m][0] * rsc, v1 = acc[ai][bj][m][1] * rsc;
                    u32x4 w; w.x = cvtpk(v0[0], v0[1]); w.y = cvtpk(v0[2], v0[3]); w.z = cvtpk(v1[0], v1[1]); w.w = cvtpk(v1[2], v1[3]);
                    *(u32x4*)(rowp + bj * HALF) = w; }
            }
    }
};
template <int ACT> struct EpiBf16 {
    static constexpr bool PERM = true;
    bf16_t* O; int ldc;
    __device__ __forceinline__ void operator()(const Acc& acc, const Unit& u, int wr, int wc, int fr, int fq) const {
        const int col0 = u.pn * BM + wc * 32 + 8 * fq;
#pragma unroll
        for (int ai = 0; ai < 2; ++ai)
#pragma unroll
            for (int m = 0; m < 4; ++m) {
                const int r = u.pm * BM + ai * HALF + wr * 64 + m * 16 + fr;
                bf16_t* rowp = O + (size_t)r * ldc + col0;
#pragma unroll
                for (int bj = 0; bj < 2; ++bj) { f32x4 v0 = acc[ai][bj][m][0], v1 = acc[ai][bj][m][1];
                    if (ACT == 1) {
#pragma unroll
                        for (int e = 0; e < 4; ++e) { const float a = fmaxf(v0[e], 0.f), b = fmaxf(v1[e], 0.f); v0[e] = a * a; v1[e] = b * b; } }
                    u32x4 w; w.x = cvtpk(v0[0], v0[1]); w.y = cvtpk(v0[2], v0[3]); w.z = cvtpk(v1[0], v1[1]); w.w = cvtpk(v1[2], v1[3]);
                    *(u32x4*)(rowp + bj * HALF) = w; }
            }
    }
};
struct EpiBranch {
    static constexpr bool PERM = true;
    bf16_t* merged; const bf16_t* gates;
    __device__ __forceinline__ void operator()(const Acc& acc, const Unit& u, int wr, int wc, int fr, int fq) const {
        const int col0 = u.pn * BM + wc * 32 + 8 * fq;
#pragma unroll
        for (int ai = 0; ai < 2; ++ai)
#pragma unroll
            for (int m = 0; m < 4; ++m) {
                const int r = u.pm * BM + ai * HALF + wr * 64 + m * 16 + fr;
                bf16_t* rowp = merged + (size_t)r * D + col0;
                const bf16_t* gp = gates + (size_t)r * GW + u.z * D + col0;
#pragma unroll
                for (int bj = 0; bj < 2; ++bj) { const f32x4 v0 = acc[ai][bj][m][0], v1 = acc[ai][bj][m][1];
                    const u32x4 gw = __builtin_nontemporal_load((const u32x4*)(gp + bj * HALF));
                    float o[8];
                    o[0] = bflo(gw.x) * v0[0]; o[1] = bfhi(gw.x) * v0[1]; o[2] = bflo(gw.y) * v0[2]; o[3] = bfhi(gw.y) * v0[3];
                    o[4] = bflo(gw.z) * v1[0]; o[5] = bfhi(gw.z) * v1[1]; o[6] = bflo(gw.w) * v1[2]; o[7] = bfhi(gw.w) * v1[3];
                    if (u.z != 0) { const u32x4 pw = *(const u32x4*)(rowp + bj * HALF);
                        o[0] += bflo(pw.x); o[1] += bfhi(pw.x); o[2] += bflo(pw.y); o[3] += bfhi(pw.y); o[4] += bflo(pw.z); o[5] += bfhi(pw.z); o[6] += bflo(pw.w); o[7] += bfhi(pw.w); }
                    u32x4 w; w.x = cvtpk(o[0], o[1]); w.y = cvtpk(o[2], o[3]); w.z = cvtpk(o[4], o[5]); w.w = cvtpk(o[6], o[7]);
                    *(u32x4*)(rowp + bj * HALF) = w; }
            }
    }
};
struct EpiRes {
    static constexpr bool PERM = false;
    const float* base; float* out; const float* modp; const float* ada_b; int layer; int gidx;
    __device__ __forceinline__ void operator()(const Acc& acc, const Unit& u, int wr, int wc, int fr, int fq) const {
        const int col0 = u.pn * BM + wc * 32 + 4 * fq;
        f32x4 gv[2][2];
#pragma unroll
        for (int bj = 0; bj < 2; ++bj)
#pragma unroll
            for (int n = 0; n < 2; ++n)
#pragma unroll
                for (int e = 0; e < 4; ++e) gv[bj][n][e] = mod_at(modp, ada_b, layer, gidx + col0 + bj * HALF + n * 16 + e);
#pragma unroll
        for (int ai = 0; ai < 2; ++ai)
#pragma unroll
            for (int m = 0; m < 4; ++m) {
                const size_t off = (size_t)(u.pm * BM + ai * HALF + wr * 64 + m * 16 + fr) * D + col0;
#pragma unroll
                for (int bj = 0; bj < 2; ++bj)
#pragma unroll
                    for (int n = 0; n < 2; ++n) { const f32x4 bs = *(const f32x4*)(base + off + bj * HALF + n * 16);
                        *(f32x4*)(out + off + bj * HALF + n * 16) = bs + gv[bj][n] * acc[ai][bj][m][n]; }
            }
    }
};
}

namespace att {
constexpr int SHM_V = 16384, SHM_K = 16384, SHM_KR = 8192, BUF = SHM_V + SHM_K + SHM_KR;
constexpr int OFF_BIAS = 2 * BUF;
constexpr int OFF_WS = OFF_BIAS + 3328;
constexpr int OFF_PRE = OFF_WS + 3072;
constexpr int OFF_QS = OFF_PRE + 1280;
constexpr int OFF_QR = OFF_QS + 256;
#define KSWZ(row, colB) ((row) * 256 + ((colB) ^ (((row) & 7) << 4)))
#define SBAR() __builtin_amdgcn_sched_barrier(0)
__device__ __forceinline__ int v_st(int k, int c) { const int kk = (k & ~0xC) | ((k & 4) << 1) | ((k & 8) >> 1); return ((kk >> 3) * 4 + (c >> 5)) * 512 + ((kk & 7) * 32 + (c & 31)) * 2; }
__device__ __forceinline__ int v_rd_base(int lane) { return ((lane & 3) << 3) | (((lane >> 2) & 3) << 6) | (((lane >> 4) & 1) << 5) | (((lane >> 5) & 1) << 8); }
constexpr int v_rd_off(int d0, int ks, int half) { return d0 * 512 + ks * 4096 + half * 2048; }
__device__ __forceinline__ int crow(int r, int hi) { return (r & 3) + 8 * (r >> 2) + 4 * hi; }

struct Unit {
    const bf16_t* Q; const bf16_t* K; const bf16_t* V; bf16_t* O; float* L; const float* btab;
    int qstride, kstride, vstride, kt0, kt1, wmax, bt, neg_next;
};

template <int DQK>
__device__ __forceinline__ void partialSM(f32x16& p0, f32x16& p1, float& m_reg, float& mn, float& alpha) {
    constexpr float SCALE = DQK == 128 ? 0.08838834764831845f : 0.07216878364870322f;
    constexpr float THR = 8.f;
    float pmax = p0[0];
#pragma unroll
    for (int r = 1; r < 16; ++r) pmax = fmaxf(pmax, p0[r]);
#pragma unroll
    for (int r = 0; r < 16; ++r) pmax = fmaxf(pmax, p1[r]);
    { auto rr = __builtin_amdgcn_permlane32_swap(__float_as_uint(pmax), __float_as_uint(pmax), false, false);
      pmax = fmaxf(__uint_as_float(rr[0]), __uint_as_float(rr[1])); }
    constexpr float C2 = 1.4426950408889634f * SCALE;
    if (__builtin_expect(__all((pmax - m_reg) * SCALE <= THR), 1)) { mn = m_reg; alpha = 1.f; }
    else { mn = fmaxf(m_reg, pmax); alpha = __builtin_amdgcn_exp2f((m_reg - mn) * C2); m_reg = mn; }
    const float mnL = -mn * C2;
#pragma unroll
    for (int r = 0; r < 16; ++r) p0[r] = __builtin_amdgcn_exp2f(fmaf(p0[r], C2, mnL));
#pragma unroll
    for (int r = 0; r < 16; ++r) p1[r] = __builtin_amdgcn_exp2f(fmaf(p1[r], C2, mnL));
}
__device__ __forceinline__ void finishSM(f32x16& p0, f32x16& p1, float alpha, float& l_reg, bf16x8& pa0, bf16x8& pa1, bf16x8& pa2, bf16x8& pa3) {
    float ps = 0;
#pragma unroll
    for (int r = 0; r < 16; ++r) ps += p0[r];
#pragma unroll
    for (int r = 0; r < 16; ++r) ps += p1[r];
    { auto rr = __builtin_amdgcn_permlane32_swap(__float_as_uint(ps), __float_as_uint(ps), false, false);
      ps = __uint_as_float(rr[0]) + __uint_as_float(rr[1]); }
    l_reg = l_reg * alpha + ps;
#define PK4(P, B_, OUT) do { unsigned a0 = cvtpk(P[B_+0], P[B_+1]), a1 = cvtpk(P[B_+2], P[B_+3]);                          \
        unsigned b0 = cvtpk(P[B_+4], P[B_+5]), b1 = cvtpk(P[B_+6], P[B_+7]);                                             \
        auto r0 = __builtin_amdgcn_permlane32_swap(a0, b0, false, false); auto r1 = __builtin_amdgcn_permlane32_swap(a1, b1, false, false); \
        u32x4 w = {r0[0], r1[0], r0[1], r1[1]}; OUT = *reinterpret_cast<bf16x8*>(&w); } while (0)
    PK4(p0, 0, pa0); PK4(p0, 8, pa1); PK4(p1, 0, pa2); PK4(p1, 8, pa3);
#undef PK4
}
template <int DQK>
__device__ __forceinline__ void qkt(f32x16& p0, f32x16& p1, const char* buf, const char* qrl, int r32, int hi, const bf16x8* qr) {
    p0 = f32x16{}; p1 = f32x16{};
    const char* K_lds = buf + SHM_V;
    const char* kb[4];
#pragma unroll
    for (int dd = 0; dd < 4; ++dd) kb[dd] = K_lds + KSWZ(r32, (dd * 16 + hi * 8) * 2);
#pragma unroll
    for (int d0 = 0; d0 < 8; ++d0) { const char* a = kb[d0 & 3] + (d0 >> 2) * 128;
        bf16x8 b0 = *reinterpret_cast<const bf16x8*>(a);
        bf16x8 b1 = *reinterpret_cast<const bf16x8*>(a + 32 * 256);
        p0 = __builtin_amdgcn_mfma_f32_32x32x16_bf16(b0, qr[d0], p0, 0, 0, 0);
        p1 = __builtin_amdgcn_mfma_f32_32x32x16_bf16(b1, qr[d0], p1, 0, 0, 0); if ((d0 & 3) == 3) SBAR(); }
    if constexpr (DQK == 192) {
        const char* KR = buf + SHM_V + SHM_K;
#pragma unroll
        for (int d1 = 0; d1 < 4; ++d1) { const char* a = KR + r32 * 128 + (((d1 * 2 + hi) * 16) ^ ((r32 & 7) << 4));
            bf16x8 b0 = *reinterpret_cast<const bf16x8*>(a);
            bf16x8 b1 = *reinterpret_cast<const bf16x8*>(a + 32 * 128);
            const bf16x8 qv = *reinterpret_cast<const bf16x8*>(qrl + r32 * 128 + (((d1 * 2 + hi) * 16) ^ ((r32 & 7) << 4)));
            p0 = __builtin_amdgcn_mfma_f32_32x32x16_bf16(b0, qv, p0, 0, 0, 0);
            p1 = __builtin_amdgcn_mfma_f32_32x32x16_bf16(b1, qv, p1, 0, 0, 0); }
    }
}
__device__ __forceinline__ void pv_tile(f32x16* o, int vb0, bf16x8 pa0, bf16x8 pa1, bf16x8 pa2, bf16x8 pa3) {
#define TRRD(dst, off) asm volatile("ds_read_b64_tr_b16 %0, %1 offset:%2" : "=&v"(dst) : "v"(vb0), "i"(off) : "memory")
#define PV_D0(d0) do { s16x4 l0, l1, l2, l3, h0, h1, h2, h3; constexpr int b_ = v_rd_off(d0, 0, 0); \
        TRRD(l0, b_); TRRD(h0, b_ + 2048); TRRD(l1, b_ + 4096); TRRD(h1, b_ + 6144); TRRD(l2, b_ + 8192); TRRD(h2, b_ + 10240); TRRD(l3, b_ + 12288); TRRD(h3, b_ + 14336); \
        asm volatile("s_waitcnt lgkmcnt(0)" ::: "memory"); SBAR();   \
        o[d0] = __builtin_amdgcn_mfma_f32_32x32x16_bf16(pa0, (bf16x8){l0[0], l0[1], l0[2], l0[3], h0[0], h0[1], h0[2], h0[3]}, o[d0], 0, 0, 0);   \
        o[d0] = __builtin_amdgcn_mfma_f32_32x32x16_bf16(pa1, (bf16x8){l1[0], l1[1], l1[2], l1[3], h1[0], h1[1], h1[2], h1[3]}, o[d0], 0, 0, 0);   \
        o[d0] = __builtin_amdgcn_mfma_f32_32x32x16_bf16(pa2, (bf16x8){l2[0], l2[1], l2[2], l2[3], h2[0], h2[1], h2[2], h2[3]}, o[d0], 0, 0, 0);   \
        o[d0] = __builtin_amdgcn_mfma_f32_32x32x16_bf16(pa3, (bf16x8){l3[0], l3[1], l3[2], l3[3], h3[0], h3[1], h3[2], h3[3]}, o[d0], 0, 0, 0); } while (0)
    PV_D0(0); PV_D0(1); PV_D0(2); PV_D0(3);
#undef PV_D0
#undef TRRD
}

template <int DQK, bool BIAS>
__device__ __forceinline__ void attn_unit(char* lds, LAS unsigned char* ldsl, const Unit& U, int qrow, int qpos, int dst, const int tid) {
    constexpr float SCALE = DQK == 128 ? 0.08838834764831845f : 0.07216878364870322f;
    const int wid = __builtin_amdgcn_readfirstlane(tid >> 6), lane = tid & 63, r32 = lane & 31, hi = lane >> 5;
    bf16x8 qr[8];
    { const bf16_t* qp = U.Q + (size_t)qrow * U.qstride + hi * 8;
#pragma unroll
      for (int d0 = 0; d0 < 8; ++d0) qr[d0] = *(const bf16x8*)(qp + d0 * 16);
      if constexpr (DQK == 192) { char* qrl = lds + OFF_QR + wid * 4096;
#pragma unroll
          for (int d1 = 0; d1 < 4; ++d1) *(bf16x8*)(qrl + r32 * 128 + (((d1 * 2 + hi) * 16) ^ ((r32 & 7) << 4))) = *(const bf16x8*)(qp + 128 + d1 * 16); } }
    float* bt = (float*)(lds + OFF_BIAS);
    if constexpr (BIAS) { for (int i = tid; i < U.bt; i += NT) bt[i] = U.btab[i]; }
    float* ws = (float*)(lds + OFF_WS) + wid * 96; float* li_l = ws; float* al_l = ws + 32; int* ds_l = (int*)(ws + 64);
    if (hi == 0) ds_l[r32] = dst;
    const unsigned offK = (unsigned)(((tid >> 4) * U.kstride + (((tid & 15) ^ ((tid >> 4) & 7)) << 3)) * 2);
    const unsigned offR = (unsigned)(((tid >> 3) * U.kstride + 128 + (((tid & 7) ^ ((tid >> 3) & 7)) << 3)) * 2);
    unsigned offV; { const int kk = ((tid >> 7) << 3) | ((tid & 31) >> 2), k = (kk & ~0xC) | ((kk & 4) << 1) | ((kk & 8) >> 1), c = (((tid >> 5) & 3) << 5) | ((tid & 3) << 3); offV = (unsigned)((k * U.vstride + c) * 2); }
#define GLDS(src, dstl) __builtin_amdgcn_global_load_lds((const unsigned*)(src), (LAS unsigned*)(dstl), 16, 0, 0)
#define DMA(tile, bf) do { const char* kb_ = (const char*)(U.K + (size_t)(tile) * 64 * U.kstride); const char* vb_ = (const char*)(U.V + (size_t)(tile) * 64 * U.vstride); \
        LAS unsigned char* d_ = ldsl + (bf) * BUF + wid * 1024; \
        GLDS(vb_ + offV, d_); GLDS(vb_ + (size_t)64 * U.vstride + offV, d_ + 8192); \
        GLDS(kb_ + offK, d_ + SHM_V); GLDS(kb_ + (size_t)64 * U.kstride + offK, d_ + SHM_V + 8192); \
        if constexpr (DQK == 192) GLDS(kb_ + offR, d_ + SHM_V + SHM_K); } while (0)
    float m_reg = -1e30f, l_reg = 0.f; f32x16 o[4] = {};
    const int nt = U.kt1 - U.kt0;
    DMA(U.kt0, 0); asm volatile("s_waitcnt vmcnt(0)" ::: "memory"); __syncthreads();
    const float NEG = -__builtin_inff();
    for (int t = 0; t < nt; ++t) {
        const int cur = t & 1, kb = (U.kt0 + t) * 64;
        if (t + 1 < nt) DMA(U.kt0 + t + 1, cur ^ 1);
        const bool lane_act = (kb <= qpos) && (qpos - (kb + 63) <= U.wmax);
        if (__any(lane_act)) {
            f32x16 p0, p1;
            qkt<DQK>(p0, p1, lds + cur * BUF, lds + OFF_QR + wid * 4096, r32, hi, qr); SBAR();
            const int dq = qpos - kb - 4 * hi;
            if constexpr (BIAS) {
                const unsigned btm = (unsigned)(U.bt - 1);
                if (__all(qpos - (kb + 63) >= U.bt - 1)) { const float cb = bt[btm];
#pragma unroll
                    for (int r = 0; r < 16; ++r) { p0[r] += cb; p1[r] += cb; } }
                else {
#pragma unroll
                    for (int r = 0; r < 16; ++r) { const int c = (r & 3) + 8 * (r >> 2);
                        unsigned i0 = (unsigned)(dq - c), i1 = (unsigned)(dq - c - 32); i0 = i0 < btm ? i0 : btm; i1 = i1 < btm ? i1 : btm;
                        p0[r] += bt[i0]; p1[r] += bt[i1]; if ((r & 3) == 3) SBAR(); } }
            }
            if (__any((kb + 63 > qpos) || (qpos - kb > U.wmax))) {
                const unsigned W = (unsigned)U.wmax;
#pragma unroll
                for (int r = 0; r < 16; ++r) { const int c = (r & 3) + 8 * (r >> 2);
                    if ((unsigned)(dq - c) > W) p0[r] = NEG;
                    if ((unsigned)(dq - c - 32) > W) p1[r] = NEG; }
            }
            float mn, alpha;
            partialSM<DQK>(p0, p1, m_reg, mn, alpha);
            if (__any(alpha < 1.f)) { if (hi == 0) al_l[r32] = alpha; asm volatile("s_waitcnt lgkmcnt(0)" ::: "memory");
#pragma unroll
                for (int d_ = 0; d_ < 4; ++d_)
#pragma unroll
                    for (int r = 0; r < 16; ++r) o[d_][r] *= al_l[crow(r, hi)]; }
            bf16x8 pa0, pa1, pa2, pa3;
            finishSM(p0, p1, alpha, l_reg, pa0, pa1, pa2, pa3); SBAR();
            const int vb0 = (int)(uintptr_t)(lds + cur * BUF) + v_rd_base(lane);
            pv_tile(o, vb0, pa0, pa1, pa2, pa3);
        }
        asm volatile("s_waitcnt vmcnt(0)" ::: "memory");
        __syncthreads();
    }
#undef DMA
#undef GLDS
    if (hi == 0) li_l[r32] = l_reg;
    if (hi == 0 && dst >= 0) { const float lse = l_reg > 0.f ? m_reg * SCALE + __logf(l_reg) : NEG; U.L[dst] = lse; if (U.neg_next) U.L[dst + 1] = NEG; }
    asm volatile("s_waitcnt lgkmcnt(0)" ::: "memory");
#pragma unroll
    for (int r = 0; r < 16; ++r) { const int orow = crow(r, hi); const float lv = li_l[orow]; const float rl = lv > 0.f ? __builtin_amdgcn_rcpf(lv) : 0.f; const int drow = ds_l[orow];
        bf16_t* orp = U.O + (size_t)(drow >= 0 ? drow : 0) * 128 + r32;
#pragma unroll
        for (int d0 = 0; d0 < 4; ++d0) { const float v = o[d0][r] * rl; const float vn = __shfl_xor(v, 1);
            if ((r32 & 1) == 0 && drow >= 0) *(unsigned*)(orp + d0 * 32) = cvtpk(v, vn); }
        if ((r & 3) == 3) SBAR(); }
}
}

__device__ __forceinline__ unsigned f2bf(float f) { unsigned u = __float_as_uint(f); return (u + 0x7fffu + ((u >> 16) & 1u)) >> 16; }
__device__ __forceinline__ unsigned pk2(float lo, float hi) { return f2bf(lo) | (f2bf(hi) << 16); }
__device__ __forceinline__ void transpose_item(const float* W, int K, int N, bf16_t* WT, int row_off, LAS float* scr, int item, int lane, const float* gk = nullptr) {
    const int nblk = N / 32, kb = item / nblk, nb = item % nblk, k0 = 64 * kb, n0 = 32 * nb;
#pragma unroll 8
    for (int i = 0; i < 32; ++i) { const int kk = 2 * i + (lane >> 5); scr[kk * 33 + (lane & 31)] = __builtin_nontemporal_load(&W[(size_t)(k0 + kk) * N + n0 + (lane & 31)]) * (gk ? gk[k0 + kk] : 1.f); }
    asm volatile("s_waitcnt lgkmcnt(0)" ::: "memory");
    const int c = lane & 7;
#pragma unroll
    for (int j = 0; j < 4; ++j) { const int n = (lane >> 3) + 8 * j; const LAS float* s = scr + (8 * c) * 33 + n;
        u32x4 o; o.x = pk2(s[0 * 33], s[1 * 33]); o.y = pk2(s[2 * 33], s[3 * 33]); o.z = pk2(s[4 * 33], s[5 * 33]); o.w = pk2(s[6 * 33], s[7 * 33]);
        __builtin_nontemporal_store(o, (u32x4*)(WT + (size_t)(row_off + n0 + n) * K + k0 + 8 * c)); }
    asm volatile("s_waitcnt lgkmcnt(0)" ::: "memory");
}

__device__ __forceinline__ void transpose_item_fp8(const float* W, int K, int N, unsigned char* WT, int row_off, LAS float* scr, int item, int lane) {
    const int nblk = N / 32, kb = item / nblk, nb = item % nblk, k0 = 64 * kb, n0 = 32 * nb;
#pragma unroll 8
    for (int i = 0; i < 32; ++i) { const int kk = 2 * i + (lane >> 5); scr[kk * 33 + (lane & 31)] = __builtin_nontemporal_load(&W[(size_t)(k0 + kk) * N + n0 + (lane & 31)]) * 64.f; }
    asm volatile("s_waitcnt lgkmcnt(0)" ::: "memory");
    const int c = lane & 7;
#pragma unroll
    for (int j = 0; j < 4; ++j) { const int n = (lane >> 3) + 8 * j; const LAS float* s = scr + (8 * c) * 33 + n;
        u32x2 o; o.x = pk4_fp8(s[0 * 33], s[1 * 33], s[2 * 33], s[3 * 33]); o.y = pk4_fp8(s[4 * 33], s[5 * 33], s[6 * 33], s[7 * 33]);
        __builtin_nontemporal_store(o, (u32x2*)(WT + (size_t)(row_off + n0 + n) * K + k0 + 8 * c)); }
    asm volatile("s_waitcnt lgkmcnt(0)" ::: "memory");
}

__device__ __forceinline__ void convert_weights(const Params& p, int layer, LAS unsigned char* ldsl) {
    const int tid = otid(), lane = tid & 63, wave = tid >> 6;
    LAS float* scr = (LAS float*)(ldsl + wave * 16384);
    const int gw = obid() * 8 + wave, NGW = gridDim.x * 8;
    unsigned char* wt = p.ws + OFF_WT;
    constexpr int I_IN = 32 * 418, I_GATE = 32 * 192, I_QB = 8 * 48, I_KVB = 8 * 64, I_BR = 16 * 64, I_O = 32 * 64, I_UP = 32 * 256, I_DN = 128 * 64;
    constexpr int NITEMS = I_IN + I_GATE + I_QB + I_KVB + 3 * I_BR + I_O + I_UP + I_DN;
    for (int it = gw; it < NITEMS; it += NGW) {
        int r = it;
        if (r < I_IN) { transpose_item_fp8(p.in[6] + (size_t)layer * D * 13376, D, 13376, wt + WT_IN, 0, scr, r, lane); continue; } r -= I_IN;
        if (r < I_GATE) { transpose_item_fp8(p.in[17] + (size_t)layer * D * GW, D, GW, wt + WT_IN, ZW, scr, r, lane); continue; } r -= I_GATE;
        if (r < I_QB) { transpose_item(p.in[8] + (size_t)layer * 512 * 1536, 512, 1536, (bf16_t*)(wt + WT_QB), 0, scr, r, lane, p.in[7] + layer * 512); continue; } r -= I_QB;
        if (r < I_KVB) { transpose_item(p.in[10] + (size_t)layer * 512 * 2048, 512, 2048, (bf16_t*)(wt + WT_KVB), 0, scr, r, lane, p.in[9] + layer * 512); continue; } r -= I_KVB;
        if (r < I_BR) { transpose_item(p.in[19] + (size_t)layer * 1024 * D, 1024, D, (bf16_t*)(wt + WT_BR), 0, scr, r, lane); continue; } r -= I_BR;
        if (r < I_BR) { transpose_item(p.in[20] + (size_t)layer * 1024 * D, 1024, D, (bf16_t*)(wt + WT_BR), 2048, scr, r, lane); continue; } r -= I_BR;
        if (r < I_BR) { transpose_item(p.in[21] + (size_t)layer * 1024 * D, 1024, D, (bf16_t*)(wt + WT_BR), 4096, scr, r, lane); continue; } r -= I_BR;
        if (r < I_O) { transpose_item(p.in[22] + (size_t)layer * D * D, D, D, (bf16_t*)(wt + WT_O), 0, scr, r, lane); continue; } r -= I_O;
        if (r < I_UP) { transpose_item(p.in[24] + (size_t)layer * D * DFF, D, DFF, (bf16_t*)(wt + WT_UP), 0, scr, r, lane); continue; } r -= I_UP;
        transpose_item(p.in[25] + (size_t)layer * DFF * D, DFF, D, (bf16_t*)(wt + WT_DN), 0, scr, r, lane);
    }
    { u32x4* zp = (u32x4*)(wt + WT_IN + (size_t)13376 * D); const int nz = 192 * D / 16;
      for (int i = obid() * NT + tid; i < nz; i += gridDim.x * NT) zp[i] = (u32x4){0u, 0u, 0u, 0u}; }
}

template <bool FP8OUT>
__device__ __forceinline__ void norm_phase(const Params& p, int layer, const float* xin, const float* gain, int sh_idx, int sc_idx, char* lds) {
    const int tid = otid(), lane = tid & 63, wave = tid >> 6;
    const float* modp = (const float*)(p.ws + OFF_MODP);
    float* gsL = (float*)lds; float* shL = gsL + D;
#pragma unroll
    for (int j = 0; j < 4; ++j) { const int col = tid * 4 + j;
        const float sc = mod_at(modp, p.in[4], layer, sc_idx + col), sh = mod_at(modp, p.in[4], layer, sh_idx + col);
        gsL[col] = gain[layer * D + col] * (1.f + sc); shL[col] = sh; }
    __syncthreads();
    bf16_t* H = (bf16_t*)(p.ws + OFF_H);
    const int gw = obid() * 8 + wave, NGW = gridDim.x * 8;
    for (int m = gw; m < S; m += NGW) {
        const f32x4* xr = (const f32x4*)(xin + (size_t)m * D) + lane;
        f32x4 v[8]; float s = 0.f;
#pragma unroll
        for (int j = 0; j < 8; ++j) { v[j] = xr[64 * j]; s += (v[j].x * v[j].x + v[j].y * v[j].y) + (v[j].z * v[j].z + v[j].w * v[j].w); }
        const float rstd = rsqrtf(wave_sum(s) * (1.f / D) + EPS);
        u32x2* o8 = (u32x2*)(H + (size_t)m * D) + lane; unsigned* o4 = (unsigned*)((unsigned char*)H + (size_t)m * D) + lane;
#pragma unroll
        for (int j = 0; j < 8; ++j) { const f32x4 g4 = *(const f32x4*)(gsL + 4 * lane + 256 * j), s4 = *(const f32x4*)(shL + 4 * lane + 256 * j);
            const f32x4 y = v[j] * rstd * g4 + s4;
            if constexpr (FP8OUT) o4[64 * j] = pk4_fp8(y.x, y.y, y.z, y.w);
            else { u32x2 w; w.x = cvtpk(y.x, y.y); w.y = cvtpk(y.z, y.w); o8[64 * j] = w; } }
    }
    __syncthreads();
}

__device__ __forceinline__ void kbar_phase(const Params& p, char* lds) {
    const int tid = otid();
    const bf16_t* z = (const bf16_t*)(p.ws + OFF_Z);
    float* kbar = (float*)(p.ws + OFF_KBAR);
    float* red = (float*)lds;
    for (int it = obid(); it < 256; it += gridDim.x) {
        const int h = it >> 5, n = it & 31, c = tid & 15, rg = tid >> 4;
        float a[8] = {0, 0, 0, 0, 0, 0, 0, 0};
#pragma unroll
        for (int i = 0; i < 8; ++i) { const u32x4 w = *(const u32x4*)(z + (size_t)(n * 256 + rg * 8 + i) * ZW + ZC_BK + h * 128 + c * 8);
            a[0] += bflo(w.x); a[1] += bfhi(w.x); a[2] += bflo(w.y); a[3] += bfhi(w.y); a[4] += bflo(w.z); a[5] += bfhi(w.z); a[6] += bflo(w.w); a[7] += bfhi(w.w); }
#pragma unroll
        for (int e = 0; e < 8; ++e) red[rg * 128 + c * 8 + e] = a[e];
        __syncthreads();
        if (tid < 128) { float s = 0.f;
#pragma unroll
            for (int g = 0; g < 32; ++g) s += red[g * 128 + tid];
            kbar[(size_t)it * 128 + tid] = s * (1.f / 256.f); }
        __syncthreads();
    }
}

__device__ __forceinline__ void mla_post_phase(const Params& p, int layer) {
    const int tid = otid(), lane = tid & 63, wave = tid >> 6, h = lane >> 3, c8 = lane & 7;
    const bf16_t* z = (const bf16_t*)(p.ws + OFF_Z);
    const bf16_t* qraw = (const bf16_t*)(p.ws + OFF_QRAW); const bf16_t* kvraw = (const bf16_t*)(p.ws + OFF_KVRAW);
    bf16_t* Qc = (bf16_t*)(p.ws + OFF_QC); bf16_t* Kc = (bf16_t*)(p.ws + OFF_KC);
    const int gw = obid() * 8 + wave, NGW = gridDim.x * 8;
    float invf[8];
#pragma unroll
    for (int e = 0; e < 8; ++e) invf[e] = exp2f(-(float)((8 * c8 + e) & 31) * (13.287712379549449f / 32.f)) * 0.15915494309189535f;
    for (int it = gw; it < S * 2; it += NGW) {
        const int t = it >> 1, isk = it & 1;
        const float* gp = (isk ? p.in[16] : p.in[15]) + layer * 192;
        u32x4 w0, w1, w2;
        if (isk) { const bf16_t* kp = kvraw + (size_t)t * 2048 + h * 256; w0 = *(const u32x4*)(kp + 8 * c8); w1 = *(const u32x4*)(kp + 64 + 8 * c8); w2 = *(const u32x4*)(z + (size_t)t * ZW + ZC_KPE + 8 * c8); }
        else { const bf16_t* qp = qraw + (size_t)t * 1536 + h * 192; w0 = *(const u32x4*)(qp + 8 * c8); w1 = *(const u32x4*)(qp + 64 + 8 * c8); w2 = *(const u32x4*)(qp + 128 + 8 * c8); }
        float x0[8], x1[8], x2[8];
        x0[0] = bflo(w0.x); x0[1] = bfhi(w0.x); x0[2] = bflo(w0.y); x0[3] = bfhi(w0.y); x0[4] = bflo(w0.z); x0[5] = bfhi(w0.z); x0[6] = bflo(w0.w); x0[7] = bfhi(w0.w);
        x1[0] = bflo(w1.x); x1[1] = bfhi(w1.x); x1[2] = bflo(w1.y); x1[3] = bfhi(w1.y); x1[4] = bflo(w1.z); x1[5] = bfhi(w1.z); x1[6] = bflo(w1.w); x1[7] = bfhi(w1.w);
        x2[0] = bflo(w2.x); x2[1] = bfhi(w2.x); x2[2] = bflo(w2.y); x2[3] = bfhi(w2.y); x2[4] = bflo(w2.z); x2[5] = bfhi(w2.z); x2[6] = bflo(w2.w); x2[7] = bfhi(w2.w);
        float ss = 0.f;
#pragma unroll
        for (int e = 0; e < 8; ++e) ss += x0[e] * x0[e] + x1[e] * x1[e] + x2[e] * x2[e];
        ss += __shfl_xor(ss, 1); ss += __shfl_xor(ss, 2); ss += __shfl_xor(ss, 4);
        const float r = rsqrtf(ss * (1.f / 192.f) + EPS);
        const f32x4 ga = *(const f32x4*)(gp + 8 * c8), gb = *(const f32x4*)(gp + 8 * c8 + 4), gc = *(const f32x4*)(gp + 64 + 8 * c8), gd = *(const f32x4*)(gp + 64 + 8 * c8 + 4),
                    ge = *(const f32x4*)(gp + 128 + 8 * c8), gf = *(const f32x4*)(gp + 128 + 8 * c8 + 4);
        const float g0[8] = {ga.x, ga.y, ga.z, ga.w, gb.x, gb.y, gb.z, gb.w}, g1[8] = {gc.x, gc.y, gc.z, gc.w, gd.x, gd.y, gd.z, gd.w}, g2[8] = {ge.x, ge.y, ge.z, ge.w, gf.x, gf.y, gf.z, gf.w};
        float y0[8], y1[8], yr[8];
#pragma unroll
        for (int e = 0; e < 8; ++e) { y0[e] = x0[e] * r * g0[e]; y1[e] = x1[e] * r * g1[e];
            const float y2 = x2[e] * r * g2[e], pr = __shfl_xor(y2, 4);
            float rev = (float)t * invf[e]; rev = rev - floorf(rev);
            const float sn = __builtin_amdgcn_sinf(rev), cs = __builtin_amdgcn_cosf(rev);
            yr[e] = (c8 < 4) ? y2 * cs - pr * sn : y2 * cs + pr * sn; }
        bf16_t* op = (isk ? Kc : Qc) + (size_t)t * 1536 + h * 192;
        u32x4 o;
        o.x = cvtpk(y0[0], y0[1]); o.y = cvtpk(y0[2], y0[3]); o.z = cvtpk(y0[4], y0[5]); o.w = cvtpk(y0[6], y0[7]); *(u32x4*)(op + 8 * c8) = o;
        o.x = cvtpk(y1[0], y1[1]); o.y = cvtpk(y1[2], y1[3]); o.z = cvtpk(y1[4], y1[5]); o.w = cvtpk(y1[6], y1[7]); *(u32x4*)(op + 64 + 8 * c8) = o;
        o.x = cvtpk(yr[0], yr[1]); o.y = cvtpk(yr[2], yr[3]); o.z = cvtpk(yr[4], yr[5]); o.w = cvtpk(yr[6], yr[7]); *(u32x4*)(op + 128 + 8 * c8) = o;
    }
}

__device__ __forceinline__ void moba_select_phase(const Params& p, int layer, char* lds) {
    const int tid = otid();
    const bf16_t* z = (const bf16_t*)(p.ws + OFF_Z);
    const float* kbar = (const float*)(p.ws + OFF_KBAR);
    int* cnt = (int*)(p.ws + OFF_CTL) + CW_CNT + layer * 256;
    int* list = (int*)(p.ws + OFF_LIST);
    float* kb = (float*)lds;
    for (int it = obid(); it < 256; it += gridDim.x) {
        const int h = it >> 5, qb = it & 31;
        if (qb > 0) {
            for (int i = tid; i < qb * 128; i += NT) kb[i] = kbar[(size_t)h * 32 * 128 + i];
            __syncthreads();
            {
                const int tok = qb * 256 + (tid >> 1), par = tid & 1;
                u32x4 q[16];
#pragma unroll
                for (int i = 0; i < 16; ++i) q[i] = *(const u32x4*)(z + (size_t)tok * ZW + ZC_BQ + h * 128 + i * 8);
                const float NEGI = -__builtin_inff();
                float b0 = NEGI, b1 = NEGI, b2 = NEGI; int i0 = -1, i1 = -1, i2 = -1;
#define INS3(d, n) do { if (d > b0 || (d == b0 && n < i0)) { b2 = b1; i2 = i1; b1 = b0; i1 = i0; b0 = d; i0 = n; } \
                        else if (d > b1 || (d == b1 && n < i1)) { b2 = b1; i2 = i1; b1 = d; i1 = n; } \
                        else if (d > b2 || (d == b2 && n < i2)) { b2 = d; i2 = n; } } while (0)
                for (int n = par; n < qb; n += 2) {
                    const f32x4* kp = (const f32x4*)(kb + n * 128);
                    float d = 0.f;
#pragma unroll
                    for (int i = 0; i < 16; ++i) { const f32x4 ka = kp[2 * i], kc = kp[2 * i + 1];
                        d += bflo(q[i].x) * ka.x + bfhi(q[i].x) * ka.y + bflo(q[i].y) * ka.z + bfhi(q[i].y) * ka.w + bflo(q[i].z) * kc.x + bfhi(q[i].z) * kc.y + bflo(q[i].w) * kc.z + bfhi(q[i].w) * kc.w; }
                    INS3(d, n);
                }
                const float c0 = __shfl_xor(b0, 1), c1 = __shfl_xor(b1, 1), c2 = __shfl_xor(b2, 1);
                const int j0 = __shfl_xor(i0, 1), j1 = __shfl_xor(i1, 1), j2 = __shfl_xor(i2, 1);
                if (j0 >= 0) INS3(c0, j0);
                if (j1 >= 0) INS3(c1, j1);
                if (j2 >= 0) INS3(c2, j2);
#undef INS3
                if (par == 0) {
                    if (i0 >= 0) { const int s = atomicAdd(&cnt[h * 32 + i0], 1); list[(size_t)(h * 32 + i0) * 8192 + s] = tok * 4 + 0; }
                    if (i1 >= 0) { const int s = atomicAdd(&cnt[h * 32 + i1], 1); list[(size_t)(h * 32 + i1) * 8192 + s] = tok * 4 + 1; }
                    if (i2 >= 0) { const int s = atomicAdd(&cnt[h * 32 + i2], 1); list[(size_t)(h * 32 + i2) * 8192 + s] = tok * 4 + 2; }
                }
            }
            __syncthreads();
        }
    }
}

__device__ __forceinline__ void attention_phase(const Params& p, int layer, char* lds, LAS unsigned char* ldsl) {
    const int tid = otid(), wid = tid >> 6, lane = tid & 63, r32 = lane & 31;
    unsigned char* ws = p.ws;
    const bf16_t* z = (const bf16_t*)(ws + OFF_Z);
    int* ctl = (int*)(ws + OFF_CTL);
    const int* cnt = ctl + CW_CNT + layer * 256;
    int* qctr = ctl + CW_QCTR + layer * 64;
    const int* list = (const int*)(ws + OFF_LIST);
    float* lseA = (float*)(ws + OFF_LSE); float* lseB = (float*)(ws + OFF_LSE + MiB); float* lseC = (float*)(ws + OFF_LSE + 2 * MiB);
    const float* btabA = (const float*)(ws + OFF_BTAB); const float* btabB = btabA + 24 * BTA_STRIDE;
    int* pre = (int*)(lds + att::OFF_PRE);
    if (tid < 256) pre[tid + 1] = (cnt[tid] + 255) >> 8;
    if (tid == 0) pre[0] = 0;
    __syncthreads();
    if (tid == 0) { int s = 0; for (int i = 1; i <= 256; ++i) { s += pre[i]; pre[i] = s; } }
    __syncthreads();
    constexpr int NC = 384, NA = 768, NBO = 256, U_A = NC, U_BO = NC + NA, U_BS = NC + NA + NBO;
    const int total = U_BS + pre[256];
    for (;;) {
        if (tid == 0) *(volatile int*)(lds + att::OFF_QS) = atomicAdd(qctr, 1);
        __syncthreads();
        const int u = __builtin_amdgcn_readfirstlane(*(volatile int*)(lds + att::OFF_QS));
        __syncthreads();
        if (u >= total) break;
        att::Unit U; int qrow, qpos, dst;
        if (u < U_A) {
            int qb, h, half, split;
            if (u < 256) { qb = 31 - (u >> 4); h = (u & 15) >> 1; half = u & 1; split = 1; } else { const int v = u - 256; qb = 15 - (v >> 3); h = v & 7; half = 0; split = 0; }
            const int T = 4 * (qb + 1);
            U.Q = (const bf16_t*)(ws + OFF_QC) + h * 192; U.qstride = 1536; U.K = (const bf16_t*)(ws + OFF_KC) + h * 192; U.kstride = 1536;
            U.V = (const bf16_t*)(ws + OFF_KVRAW) + h * 256 + 128; U.vstride = 2048;
            U.O = (bf16_t*)(ws + OFF_PC); U.L = lseC; U.btab = nullptr; U.bt = 0; U.wmax = 0x7fffffff; U.neg_next = split ? 0 : 1;
            if (split) { U.kt0 = half ? T / 2 : 0; U.kt1 = half ? T : T / 2; } else { U.kt0 = 0; U.kt1 = T; }
            const int tok = qb * 256 + wid * 32 + r32; qrow = tok; qpos = tok; dst = (tok * 8 + h) * 2 + half;
            att::attn_unit<192, false>(lds, ldsl, U, qrow, qpos, dst, tid);
        } else {
            if (u < U_BO) {
                const int a = u - U_A, gh = a >> 5, qblk = a & 31, g = gh >> 3, h = gh & 7, lg = 2 * g, L = S >> lg;
                const int rowbase = qblk * 256, seq0 = rowbase & ~(L - 1), i0 = rowbase - seq0, res = seq0 >> (13 - lg);
                const bf16_t* zb = z + (size_t)seq0 * ZW + g * 1024 + h * 128;
                U.Q = zb + ZC_AQ; U.K = zb + ZC_AK; U.V = zb + ZC_AV; U.qstride = U.kstride = U.vstride = ZW;
                U.O = (bf16_t*)(ws + OFF_PA); U.L = lseA; U.btab = btabA + (g * 8 + h) * BTA_STRIDE; U.bt = BTA; U.wmax = 128; U.neg_next = 0;
                U.kt0 = (i0 >= 128 ? i0 - 128 : 0) >> 6; U.kt1 = (i0 + 256) >> 6;
                qrow = i0 + wid * 32 + r32; qpos = qrow; const int tok = (qrow << lg) + res; dst = (tok * 8 + h) * 3 + g;
            } else if (u < U_BS) {
                const int b = u - U_BO, h = b >> 5, qb = b & 31;
                U.Q = z + ZC_BQ + h * 128; U.K = z + ZC_BK + h * 128; U.V = z + ZC_BV + h * 128; U.qstride = U.kstride = U.vstride = ZW;
                U.O = (bf16_t*)(ws + OFF_PB); U.L = lseB; U.btab = btabB + h * BTB; U.bt = BTB; U.wmax = 0x7fffffff; U.neg_next = 0;
                U.kt0 = qb * 4; U.kt1 = qb * 4 + 4;
                const int tok = qb * 256 + wid * 32 + r32; qrow = tok; qpos = tok; dst = (tok * 8 + h) * 4 + 3;
            } else {
                const int c = u - U_BS; int lo = 0, hi_ = 256;
                while (hi_ - lo > 1) { const int mid = (lo + hi_) >> 1; if (pre[mid] <= c) lo = mid; else hi_ = mid; }
                const int e = lo, h = e >> 5, n = e & 31, chunk = c - pre[e], idx = chunk * 256 + wid * 32 + r32;
                U.Q = z + ZC_BQ + h * 128; U.K = z + ZC_BK + h * 128; U.V = z + ZC_BV + h * 128; U.qstride = U.kstride = U.vstride = ZW;
                U.O = (bf16_t*)(ws + OFF_PB); U.L = lseB; U.btab = btabB + h * BTB; U.bt = BTB; U.wmax = 0x7fffffff; U.neg_next = 0;
                U.kt0 = n * 4; U.kt1 = n * 4 + 4;
                if (idx < cnt[e]) { const int ent = list[(size_t)e * 8192 + idx]; const int tok = ent >> 2; qrow = tok; qpos = tok; dst = (tok * 8 + h) * 4 + (ent & 3); }
                else { qrow = (n + 1) * 256; qpos = qrow; dst = -1; }
            }
            att::attn_unit<128, true>(lds, ldsl, U, qrow, qpos, dst, tid);
        }
    }
}

__device__ __forceinline__ void combine_phase(const Params& p) {
    unsigned char* ws = p.ws;
    const float* lseA = (const float*)(ws + OFF_LSE); const float* lseB = (const float*)(ws + OFF_LSE + MiB); const float* lseC = (const float*)(ws + OFF_LSE + 2 * MiB);
    bf16_t* Y = (bf16_t*)(ws + OFF_Y);
    const int total = S * 3 * 8 * 16;
    for (int i = obid() * NT + otid(); i < total; i += gridDim.x * NT) {
        const int ch = i & 15, h = (i >> 4) & 7, rest = i >> 7, br = rest % 3, t = rest / 3;
        const int np = br == 0 ? 3 : (br == 1 ? 4 : 2);
        const float* lp = br == 0 ? lseA + (size_t)(t * 8 + h) * 3 : (br == 1 ? lseB + (size_t)(t * 8 + h) * 4 : lseC + (size_t)(t * 8 + h) * 2);
        const bf16_t* op = (const bf16_t*)(ws + (br == 0 ? OFF_PA : (br == 1 ? OFF_PB : OFF_PC))) + (size_t)(t * 8 + h) * np * 128 + ch * 8;
        float l[4]; float M = -__builtin_inff();
#pragma unroll
        for (int k = 0; k < 4; ++k) { bool valid = k < np; if (br == 1 && k < 3) valid = k < (t >> 8);
            l[k] = valid ? lp[k < np ? k : 0] : -__builtin_inff(); M = fmaxf(M, l[k]); }
        float acc[8] = {0, 0, 0, 0, 0, 0, 0, 0}; float sum = 0.f;
#pragma unroll
        for (int k = 0; k < 4; ++k) { const float w = __expf(l[k] - M);
            if (l[k] > -3.0e38f && w > 0.f) { sum += w; const u32x4 v = __builtin_nontemporal_load((const u32x4*)(op + (size_t)k * 128));
                acc[0] += w * bflo(v.x); acc[1] += w * bfhi(v.x); acc[2] += w * bflo(v.y); acc[3] += w * bfhi(v.y); acc[4] += w * bflo(v.z); acc[5] += w * bfhi(v.z); acc[6] += w * bflo(v.w); acc[7] += w * bfhi(v.w); } }
        const float rs = __builtin_amdgcn_rcpf(sum);
        u32x4 w; w.x = cvtpk(acc[0] * rs, acc[1] * rs); w.y = cvtpk(acc[2] * rs, acc[3] * rs); w.z = cvtpk(acc[4] * rs, acc[5] * rs); w.w = cvtpk(acc[6] * rs, acc[7] * rs);
        *(u32x4*)(Y + (size_t)t * 3072 + br * 1024 + h * 128 + ch * 8) = w;
    }
}

#define XB_TMO      128
#define XB_XCNT(j)  (256  + 64 * (j))
#define XB_XSUB(j)  (1280 + 64 * (j))
#define XB_XGEN(j)  (2304 + 64 * (j))
#define XB_TOP      3328
#define XB_TOPGEN   3392
#define XCD_BAR_WORDS 3456
#define XB_SPIN_CAP (1u << 18)

__device__ __forceinline__ unsigned xb_ld(unsigned* p)              { return __hip_atomic_load(p, __ATOMIC_RELAXED, __HIP_MEMORY_SCOPE_AGENT); }
__device__ __forceinline__ unsigned xb_add(unsigned* p, unsigned v) { return __hip_atomic_fetch_add(p, v, __ATOMIC_RELAXED, __HIP_MEMORY_SCOPE_AGENT); }
__device__ __forceinline__ unsigned xb_xcc_id() { return (unsigned)__builtin_amdgcn_s_getreg((3 << 11) | 20) & 0xFu; }
#define XB_SPIN(cond, bar) do { unsigned _sp = 0; while (cond) { __builtin_amdgcn_s_sleep(1); \
    if ((++_sp & 255u) == 0u) { if (xb_ld(&(bar)[XB_TMO])) break; if (_sp > XB_SPIN_CAP) { atomicAdd(&(bar)[XB_TMO], 1u); break; } } } } while (0)

struct XcdBarrier {
    unsigned* bar; unsigned x;
    volatile LAS unsigned* st;
};

__device__ __forceinline__ XcdBarrier xcd_barrier_post(unsigned* bar, volatile LAS unsigned* st) {
    XcdBarrier b; b.bar = bar; b.x = xb_xcc_id(); b.st = st;
    if (otid() == 0) (void)xb_add(&bar[XB_XCNT(b.x)], 1u);
    return b;
}
__device__ __forceinline__ void xcd_barrier_complete(unsigned* bar, unsigned x, unsigned& nloc, unsigned& nx) {
    const unsigned G = gridDim.x * gridDim.y * gridDim.z;
    unsigned sum, cnt, mine, sp = 0u;
    for (;;) {
        sum = 0u; cnt = 0u; mine = 0u;
#pragma unroll
        for (unsigned j = 0; j < 16; ++j) { const unsigned c = xb_ld(&bar[XB_XCNT(j)]); sum += c; cnt += (c > 0u) ? 1u : 0u; mine = (j == x) ? c : mine; }
        if (sum == G) break;
        __builtin_amdgcn_s_sleep(1);
        if ((++sp & 255u) == 0u) { if (xb_ld(&bar[XB_TMO])) break; if (sp > XB_SPIN_CAP) { atomicAdd(&bar[XB_TMO], 1u); break; } }
    }
    nloc = mine > 0u ? mine : 1u; nx = cnt > 0u ? cnt : 1u;
}

__device__ __forceinline__ void xcd_barrier(const XcdBarrier& b) {
    asm volatile("s_waitcnt vmcnt(0)" ::: "memory");
    __syncthreads();
    if (otid() == 0) {
        unsigned* bar = b.bar;
        __builtin_amdgcn_s_waitcnt(0);
        unsigned nloc = b.st[0], nx = b.st[1];
        if (nloc == 0u) { xcd_barrier_complete(bar, b.x, nloc, nx); b.st[0] = nloc; b.st[1] = nx; }
        const unsigned old = xb_add(&bar[XB_XSUB(b.x)], 1u);
        const unsigned gen = old / nloc;
        if (old + 1u == (gen + 1u) * nloc) {
            __builtin_amdgcn_fence(__ATOMIC_RELEASE, "agent");
            asm volatile("s_waitcnt vmcnt(0)" ::: "memory");
            const unsigned og = xb_add(&bar[XB_TOP], 1u);
            const unsigned tg = og / nx;
            if (og + 1u == (tg + 1u) * nx) xb_add(&bar[XB_TOPGEN], 1u);
            else XB_SPIN(xb_ld(&bar[XB_TOPGEN]) == tg, bar);
            __builtin_amdgcn_fence(__ATOMIC_ACQUIRE, "agent");
            xb_add(&bar[XB_XGEN(b.x)], 1u);
            asm volatile("s_waitcnt vmcnt(0)" ::: "memory");
        } else {
            XB_SPIN(xb_ld(&bar[XB_XGEN(b.x)]) == gen, bar);
            __builtin_amdgcn_fence(__ATOMIC_ACQUIRE, "agent");
            asm volatile("s_waitcnt vmcnt(0)" ::: "memory");
        }
    }
    __syncthreads();
}

typedef const __attribute__((address_space(4))) Params* KP;
__device__ __forceinline__ Params ldparams() {
    KP q = (KP)__builtin_amdgcn_kernarg_segment_ptr(); asm volatile("" : "+s"(q));
    Params r;
#pragma unroll
    for (int i = 0; i < 26; ++i) r.in[i] = q->in[i];
    r.out = q->out; r.ws = q->ws; return r;
}

template <int LAYER>
__device__ __forceinline__ void layer_body(const XcdBarrier& xb, char* lds, LAS unsigned char* ldsl) {
    constexpr int layer = LAYER;
    if (layer == 1) { const Params p = ldparams(); convert_weights(p, 1, ldsl); __syncthreads(); }
    { const Params p = ldparams(); norm_phase<true>(p, layer, layer == 0 ? p.in[0] : p.out, p.in[5], 0, 2048, lds); }
    xcd_barrier(xb);
    { const Params p = ldparams(); unsigned char* ws = p.ws;
      pg8::Gemm g{(const bf16_t*)(ws + OFF_H), (const bf16_t*)(ws + OFF_WT + WT_IN), D, D, D, 0, 0};
      pg8::StaticOrder so; so.init(S, NIN, gridDim.x, obid());
      pg8::EpiIn E{(bf16_t*)(ws + OFF_Z), (bf16_t*)(ws + OFF_GATES), p.in[18] + layer * GW, p.in[11] + layer * 128, p.in[12] + layer * 128, p.in[13] + layer * 128, p.in[14] + layer * 128,
                   (float*)(ws + OFF_SSQC), (LAS float*)(ldsl + LDS_XCH)};
      pg8::gemm_phase<pg8::EpiIn, pg8::StaticOrder, true, true>(ldsl, g, so, E); }
    xcd_barrier(xb);
    { const Params p = ldparams(); kbar_phase(p, lds); }
    { const Params p = ldparams(); unsigned char* ws = p.ws;
      pg8::Gemm g{(const bf16_t*)(ws + OFF_Z) + ZC_CQ, (const bf16_t*)(ws + OFF_WT + WT_QB), 512, ZW, 512, 0, 0};
      pg8::StaticOrder so; so.init(S, 1536, gridDim.x, obid());
      pg8::EpiRowScale E{(bf16_t*)(ws + OFF_QRAW), 1536, (const float*)(ws + OFF_SSQC), 0};
      pg8::gemm_phase<pg8::EpiRowScale, pg8::StaticOrder, true>(ldsl, g, so, E); }
    { const Params p = ldparams(); unsigned char* ws = p.ws;
      pg8::Gemm g{(const bf16_t*)(ws + OFF_Z) + ZC_CKV, (const bf16_t*)(ws + OFF_WT + WT_KVB), 512, ZW, 512, 0, 0};
      pg8::StaticOrder so; so.init(S, 2048, gridDim.x, obid());
      pg8::EpiRowScale E{(bf16_t*)(ws + OFF_KVRAW), 2048, (const float*)(ws + OFF_SSQC), 2};
      pg8::gemm_phase<pg8::EpiRowScale, pg8::StaticOrder, true>(ldsl, g, so, E); }
    xcd_barrier(xb);
    { const Params p = ldparams(); mla_post_phase(p, layer); }
    { const Params p = ldparams(); moba_select_phase(p, layer, lds); }
    xcd_barrier(xb);
    { const Params p = ldparams(); attention_phase(p, layer, lds, ldsl); }
    xcd_barrier(xb);
    { const Params p = ldparams(); combine_phase(p); }
    xcd_barrier(xb);
    { const Params p = ldparams(); unsigned char* ws = p.ws;
      pg8::Gemm g{(const bf16_t*)(ws + OFF_Y), (const bf16_t*)(ws + OFF_WT + WT_BR), 1024, 3072, 1024, (size_t)1024 * 2, (size_t)2048 * 1024 * 2};
      pg8::BranchOrder bo{(int)gridDim.x, obid()};
      pg8::EpiBranch E{(bf16_t*)(ws + OFF_MERGED), (const bf16_t*)(ws + OFF_GATES)};
      pg8::gemm_phase<pg8::EpiBranch, pg8::BranchOrder, false>(ldsl, g, bo, E); }
    xcd_barrier(xb);
    { const Params p = ldparams(); unsigned char* ws = p.ws;
      pg8::Gemm g{(const bf16_t*)(ws + OFF_MERGED), (const bf16_t*)(ws + OFF_WT + WT_O), D, D, D, 0, 0};
      pg8::StaticOrder so; so.init(S, D, gridDim.x, obid());
      pg8::EpiRes E{layer == 0 ? p.in[0] : p.out, (float*)(ws + OFF_X1), (const float*)(ws + OFF_MODP), p.in[4], layer, 4096};
      pg8::gemm_phase<pg8::EpiRes, pg8::StaticOrder, false>(ldsl, g, so, E); }
    xcd_barrier(xb);
    { const Params p = ldparams(); norm_phase<false>(p, layer, (const float*)(p.ws + OFF_X1), p.in[23], 6144, 8192, lds); }
    xcd_barrier(xb);
    { const Params p = ldparams(); unsigned char* ws = p.ws;
      pg8::Gemm g{(const bf16_t*)(ws + OFF_H), (const bf16_t*)(ws + OFF_WT + WT_UP), D, D, D, 0, 0};
      pg8::StaticOrder so; so.init(S, DFF, gridDim.x, obid());
      pg8::EpiBf16<1> E{(bf16_t*)(ws + OFF_U), DFF};
      pg8::gemm_phase<pg8::EpiBf16<1>, pg8::StaticOrder, true>(ldsl, g, so, E); }
    xcd_barrier(xb);
    { const Params p = ldparams(); unsigned char* ws = p.ws;
      pg8::Gemm g{(const bf16_t*)(ws + OFF_U), (const bf16_t*)(ws + OFF_WT + WT_DN), DFF, DFF, DFF, 0, 0};
      pg8::StaticOrder so; so.init(S, D, gridDim.x, obid());
      pg8::EpiRes E{(const float*)(ws + OFF_X1), p.out, (const float*)(ws + OFF_MODP), p.in[4], layer, 10240};
      pg8::gemm_phase<pg8::EpiRes, pg8::StaticOrder, false>(ldsl, g, so, E); }
}

__device__ __forceinline__ void prologue_phase(const Params& p, char* lds) {
    const int tid = otid(), bid = obid(), G = gridDim.x;
    unsigned char* ws = p.ws;
    float* modp = (float*)(ws + OFF_MODP);
    if (bid == 0) { int* ctl = (int*)(ws + OFF_CTL); for (int i = tid; i < 4096; i += NT) ctl[i] = 0; }
    { float* btab = (float*)(ws + OFF_BTAB); const float* rel = p.in[2];
      const int nA = 24 * BTA_STRIDE, nB = 8 * BTB;
      for (int i = bid * NT + tid; i < nA + nB; i += G * NT) {
          float v;
          if (i < nA) { const int col = i / BTA_STRIDE, j = i % BTA_STRIDE, g = col >> 3; v = j < BTA ? rel[t5_bucket(j << (2 * g)) * 32 + col] : 0.f; }
          else { const int k = i - nA, h = k / BTB, d = k % BTB; v = rel[t5_bucket(d) * 32 + 24 + h]; }
          btab[i] = v * 11.313708498984761f;
      } }
    { float* cact = (float*)lds;
      for (int i = tid; i < D; i += NT) { const float c = p.in[1][i]; cact[i] = c / (1.f + __expf(-c)); }
      __syncthreads();
      for (int it = bid; it < 2 * KSPLIT * 6; it += G) {
          const int layer = it / (KSPLIT * 6), r = it % (KSPLIT * 6), ks = r / 6, chunk = r % 6, col = chunk * 2048 + tid * 4, k0 = ks * (D / KSPLIT);
          const float* W = p.in[3] + (size_t)layer * D * 12288 + (size_t)k0 * 12288 + col;
          f32x4 acc = {0.f, 0.f, 0.f, 0.f};
#pragma unroll 8
          for (int k = 0; k < D / KSPLIT; ++k) acc += __builtin_nontemporal_load((const f32x4*)(W + (size_t)k * 12288)) * cact[k0 + k];
          *(f32x4*)(modp + (size_t)(layer * KSPLIT + ks) * 12288 + col) = acc;
      }
      __syncthreads(); }
}

__global__ void __launch_bounds__(NT, 2) fwd_megakernel(Params pk) {
    extern __shared__ __attribute__((aligned(16))) unsigned char lds_raw[];
    cg::grid_group grid = cg::this_grid();
    char* lds = (char*)lds_raw; LAS unsigned char* ldsl = (LAS unsigned char*)lds_raw;
    (void)pk;
    if (threadIdx.x < 2) ((volatile LAS unsigned*)(ldsl + LDS_MISC))[threadIdx.x] = 0u;
    if ((threadIdx.x & 63) == 0) ((volatile LAS int*)(ldsl + LDS_WTAB))[__builtin_amdgcn_s_getreg((5 << 11) | 4) & 63u] = (int)(threadIdx.x >> 6);
    __syncthreads();
    XcdBarrier xb;
    { const Params p = ldparams(); xb = xcd_barrier_post((unsigned*)(p.ws + OFF_CTL) + CW_BAR, (volatile LAS unsigned*)(ldsl + LDS_MISC));
      if (p.ws == nullptr) grid.sync(); }
    { const Params p = ldparams(); prologue_phase(p, lds); }
    { const Params p = ldparams(); convert_weights(p, 0, ldsl); }
    xcd_barrier(xb);
    layer_body<0>(xb, lds, ldsl);
    xcd_barrier(xb);
    layer_body<1>(xb, lds, ldsl);
}

extern "C" void kernel_launch(void* const* d_in, const int* in_sizes, int n_in, void* d_out, int out_size, void* d_ws, size_t ws_size, hipStream_t stream) {
    static int grid_blocks = 0;
    if (grid_blocks == 0) {
        if (n_in != 26 || ws_size < WS_END) { fprintf(stderr, "kernel_launch: unexpected n_in %d or ws_size %zu (< %zu)\n", n_in, ws_size, (size_t)WS_END); grid_blocks = -1; return; }
        int dev = 0, cus = 0, per_cu = 0;
        (void)hipGetDevice(&dev);
        (void)hipDeviceGetAttribute(&cus, hipDeviceAttributeMultiprocessorCount, dev);
        if (hipFuncSetAttribute((const void*)fwd_megakernel, hipFuncAttributeMaxDynamicSharedMemorySize, LDS_BYTES) != hipSuccess) { fprintf(stderr, "kernel_launch: hipFuncSetAttribute failed\n"); grid_blocks = -1; return; }
        if (hipOccupancyMaxActiveBlocksPerMultiprocessor(&per_cu, (const void*)fwd_megakernel, NT, LDS_BYTES) != hipSuccess || per_cu < 1) { fprintf(stderr, "kernel_launch: occupancy query gave %d\n", per_cu); per_cu = 1; }
        (void)hipGetLastError();
        if (cus <= 0) cus = 256;
        grid_blocks = cus * (per_cu > 1 ? 1 : per_cu);
    }
    if (grid_blocks < 0) return;
    if (hipMemsetAsync((char*)d_ws + OFF_CTL + (size_t)CW_BAR * 4, 0, (size_t)XCD_BAR_WORDS * 4, stream) != hipSuccess) { fprintf(stderr, "kernel_launch: memset of the barrier words failed\n"); return; }
    Params p{};
    for (int i = 0; i < 26; ++i) p.in[i] = (const float*)d_in[i];
    p.out = (float*)d_out; p.ws = (unsigned char*)d_ws;
    void* args[] = {&p};
    hipError_t e = hipLaunchCooperativeKernel((const void*)fwd_megakernel, dim3(grid_blocks), dim3(NT), args, LDS_BYTES, stream);
    if (e != hipSuccess) fprintf(stderr, "cooperative launch failed: %s (grid %d)\n", hipGetErrorString(e), grid_blocks);
}
```
